# Optimizing an MI355X kernel written in HIP

```python
import math
import jax, jax.numpy as jnp
from jax import lax
import numpy as np

D_MODEL = 2048
BATCH = 16
SEQ = 2048
DEPTH = 1

PLE_DIM = 256
MIX_WIDTH = D_MODEL
LRU_WIDTH = MIX_WIDTH // 2
LRU_BLOCKS = 16
LRU_BLOCK_DIM = LRU_WIDTH // LRU_BLOCKS
CONV_WIDTH = 4
LRU_C = 8.0
HEAD_DIM = 64
N_HEADS = (MIX_WIDTH - LRU_WIDTH) // HEAD_DIM
N_KV = 4
HEADS_PER_KV = N_HEADS // N_KV
KV_W = N_KV * HEAD_DIM
CMP_LEN = 32
CMP_STRIDE = 16
CMP_HIDDEN = 256
SEL_BLOCK = 64
N_SELECT = 16
N_LOCAL_FORCED = 2
WINDOW = 512
Q_BLOCK = 128
SEL_Q_CHUNK = 32
N_BUCKETS = 32
MAX_DISTANCE = 128
D_FF = 4 * D_MODEL
NORM_EPS = 1e-6
NEG_INF = -1e30
FORCE_SCORE = 1e4

IN_SIZES = (LRU_WIDTH, LRU_WIDTH, N_HEADS * HEAD_DIM, KV_W, KV_W, KV_W, KV_W, KV_W, KV_W, 3 * N_HEADS)
IN_DIM = sum(IN_SIZES)
SPLIT_POINTS = tuple(int(v) for v in np.cumsum(IN_SIZES)[:-1])

kernel_name = "hymba_rglru_nsa_hybrid_layer"


def rms_norm(x, g):
    xf = x.astype(jnp.float32)
    y = xf * lax.rsqrt(jnp.mean(xf * xf, axis=-1, keepdims=True) + NORM_EPS)
    return (y * g.astype(jnp.float32)).astype(x.dtype)


def rel_bucket(dist):
    n = jnp.maximum(dist, 0)
    max_exact = N_BUCKETS // 2
    nf = jnp.maximum(n, 1).astype(jnp.float32)
    large = max_exact + (jnp.log(nf / max_exact) / math.log(MAX_DISTANCE / max_exact)
                         * (N_BUCKETS - max_exact)).astype(jnp.int32)
    large = jnp.minimum(large, N_BUCKETS - 1)
    return jnp.where(n < max_exact, n, large)


def rglru_mixer(u, gate_in, conv_w, conv_b, wa, ba, wx, bx, lam):
    B, S = u.shape[0], u.shape[1]
    up = jnp.pad(u, ((0, 0), (CONV_WIDTH - 1, 0), (0, 0)))
    xc = conv_b + sum(up[:, k:k + S] * conv_w[k] for k in range(CONV_WIDTH))
    xb = xc.reshape(B, S, LRU_BLOCKS, LRU_BLOCK_DIM)
    r = jax.nn.sigmoid(jnp.einsum('bsni,nij->bsnj', xb, wa) + ba).reshape(B, S, LRU_WIDTH)
    ig = jax.nn.sigmoid(jnp.einsum('bsni,nij->bsnj', xb, wx) + bx).reshape(B, S, LRU_WIDTH)
    log_a = -LRU_C * r.astype(jnp.float32) * jax.nn.softplus(-lam.astype(jnp.float32))
    a = jnp.exp(log_a)
    b = jnp.sqrt(-jnp.expm1(2.0 * log_a)) * (ig * xc).astype(jnp.float32)

    def combine(left, right):
        a1, b1 = left
        a2, b2 = right
        return a1 * a2, a2 * b1 + b2

    _, h = lax.associative_scan(combine, (a, b), axis=1)
    return h.astype(u.dtype) * jax.nn.gelu(gate_in)


def nsa_mixer(q, k_c, v_c, k_s, v_s, k_w, v_w, gates,
              pe_k, w1_k, w2_k, pe_v, w1_v, w2_v, rel_bias):
    B, S = q.shape[0], q.shape[1]
    G, R, dk = N_KV, HEADS_PER_KV, HEAD_DIM
    q = q.reshape(B, S, G, R, dk)
    k_c, v_c, k_s, v_s, k_w, v_w = [t.reshape(B, S, G, dk) for t in (k_c, v_c, k_s, v_s, k_w, v_w)]
    scale = dk ** -0.5
    pos = jnp.arange(S, dtype=jnp.int32)
    bias_tab = rel_bias.astype(jnp.float32).reshape(N_BUCKETS, G, R)

    n_cmp = (S - CMP_LEN) // CMP_STRIDE + 1
    cmp_idx = np.arange(n_cmp)[:, None] * CMP_STRIDE + np.arange(CMP_LEN)[None, :]

    def compress(t, pe, w1, w2):
        blk = t[:, cmp_idx] + pe[:, None, :]
        blk = blk.transpose(0, 1, 3, 2, 4).reshape(B, n_cmp, G, CMP_LEN * dk)
        return jax.nn.gelu(blk @ w1) @ w2

    kc = compress(k_c, pe_k, w1_k, w2_k)
    vc = compress(v_c, pe_v, w1_v, w2_v)
    cmp_end = jnp.asarray(np.arange(n_cmp) * CMP_STRIDE + CMP_LEN - 1, dtype=jnp.int32)
    dist_c = pos[:, None] - cmp_end[None, :]
    valid_c = dist_c >= 0
    bias_c = bias_tab[rel_bucket(dist_c)].transpose(2, 3, 0, 1)
    s_c = jnp.einsum('bsgrd,bngd->bgrsn', q, kc).astype(jnp.float32) * scale + bias_c
    s_c = jnp.where(valid_c, s_c, NEG_INF)
    any_c = (pos >= CMP_LEN - 1)[:, None]
    p_c = jax.nn.softmax(s_c, axis=-1) * any_c
    o_c = jnp.einsum('bgrsn,bngd->bsgrd', p_c.astype(vc.dtype), vc)

    n_sel = S // SEL_BLOCK
    ratio_sel = SEL_BLOCK // CMP_STRIDE
    ratio_cmp = CMP_LEN // CMP_STRIDE
    jj_np = np.arange(n_sel)[:, None, None]
    ci = ratio_sel * jj_np + np.arange(ratio_sel)[None, :, None] - np.arange(ratio_cmp)[None, None, :]
    jb = np.broadcast_to(jj_np, ci.shape)
    ok = (ci >= 0) & (ci < n_cmp)
    M = np.zeros((n_cmp, n_sel), np.float32)
    np.add.at(M, (ci[ok], jb[ok]), 1.0)
    imp = jnp.einsum('bgrsn,nj->bgsj', p_c, jnp.asarray(M))
    jj = jnp.arange(n_sel, dtype=jnp.int32)
    dblk = (pos // SEL_BLOCK)[:, None] - jj[None, :]
    forced = (jj[None, :] == 0) | ((dblk >= 0) & (dblk < N_LOCAL_FORCED))
    causal_blk = dblk >= 0
    imp = jnp.where(forced, FORCE_SCORE, jnp.where(causal_blk, imp, -FORCE_SCORE))
    n_top = min(N_SELECT, n_sel)
    _, sel_idx = lax.top_k(imp, n_top)

    kb = k_s.reshape(B, n_sel, SEL_BLOCK, G, dk).transpose(0, 3, 1, 2, 4)
    vb = v_s.reshape(B, n_sel, SEL_BLOCK, G, dk).transpose(0, 3, 1, 2, 4)
    n_ch = S // SEL_Q_CHUNK
    q_ch = q.reshape(B, n_ch, SEL_Q_CHUNK, G, R, dk).transpose(1, 0, 2, 3, 4, 5)
    idx_ch = sel_idx.reshape(B, G, n_ch, SEL_Q_CHUNK, n_top).transpose(2, 0, 1, 3, 4)
    pos_ch = pos.reshape(n_ch, SEL_Q_CHUNK)
    b_ar = jnp.arange(B)[:, None, None]
    g_ar = jnp.arange(G)[None, :, None]
    g_ar4 = jnp.arange(G)[None, :, None, None]
    n_keys = n_top * SEL_BLOCK
    in_blk = jnp.arange(SEL_BLOCK, dtype=jnp.int32)

    def sel_chunk(args):
        qc, ic, tc = args
        flat = ic.reshape(B, G, SEL_Q_CHUNK * n_top)
        ks = kb[b_ar, g_ar, flat].reshape(B, G, SEL_Q_CHUNK, n_keys, dk)
        vs = vb[b_ar, g_ar, flat].reshape(B, G, SEL_Q_CHUNK, n_keys, dk)
        kpos = (ic[..., None] * SEL_BLOCK + in_blk).reshape(B, G, SEL_Q_CHUNK, n_keys)
        dist = tc[None, None, :, None] - kpos
        bias = bias_tab[rel_bucket(dist), g_ar4].transpose(0, 1, 4, 2, 3)
        s = jnp.einsum('bqgrd,bgqkd->bgrqk', qc, ks).astype(jnp.float32) * scale + bias
        s = jnp.where((dist >= 0)[:, :, None], s, NEG_INF)
        pr = jax.nn.softmax(s, axis=-1)
        return jnp.einsum('bgrqk,bgqkd->bqgrd', pr.astype(vs.dtype), vs)

    o_s = lax.map(sel_chunk, (q_ch, idx_ch, pos_ch))
    o_s = o_s.transpose(1, 0, 2, 3, 4, 5).reshape(B, S, G, R, dk)

    n_qb = S // Q_BLOCK
    band = Q_BLOCK + WINDOW
    kw_pad = jnp.pad(k_w, ((0, 0), (WINDOW, 0), (0, 0), (0, 0)))
    vw_pad = jnp.pad(v_w, ((0, 0), (WINDOW, 0), (0, 0), (0, 0)))
    kj = jnp.arange(band, dtype=jnp.int32)[None, :]
    dist_w = WINDOW + jnp.arange(Q_BLOCK, dtype=jnp.int32)[:, None] - kj
    band_ok = (dist_w >= 0) & (dist_w < WINDOW)
    bias_w = bias_tab[rel_bucket(dist_w)].transpose(2, 3, 0, 1)
    q_blk = q.reshape(B, n_qb, Q_BLOCK, G, R, dk).transpose(1, 0, 2, 3, 4, 5)
    starts = jnp.arange(n_qb, dtype=jnp.int32) * Q_BLOCK

    def win_block(args):
        qb, st = args
        kw = lax.dynamic_slice_in_dim(kw_pad, st, band, axis=1)
        vw = lax.dynamic_slice_in_dim(vw_pad, st, band, axis=1)
        ok_w = band_ok & (st - WINDOW + kj >= 0)
        s = jnp.einsum('bqgrd,bkgd->bgrqk', qb, kw).astype(jnp.float32) * scale + bias_w
        s = jnp.where(ok_w, s, NEG_INF)
        pr = jax.nn.softmax(s, axis=-1)
        return jnp.einsum('bgrqk,bkgd->bqgrd', pr.astype(vw.dtype), vw)

    o_w = lax.map(win_block, (q_blk, starts))
    o_w = o_w.transpose(1, 0, 2, 3, 4, 5).reshape(B, S, G, R, dk)

    gt = jax.nn.sigmoid(gates).reshape(B, S, G, R, 3)
    o = gt[..., 0:1] * o_c + gt[..., 1:2] * o_s + gt[..., 2:3] * o_w
    return o.reshape(B, S, N_HEADS * dk)


def setup_inputs(seed: int = 0) -> dict:
    key = jax.random.key(seed)
    ks = jax.random.split(key, 32)
    f32 = jnp.float32

    def nrm(k, shape, scale):
        return jax.random.normal(k, shape, f32) * scale

    def gain(k, shape):
        return 1.0 + 0.05 * jax.random.normal(k, shape, f32)

    a0 = jax.random.uniform(ks[10], (DEPTH, LRU_WIDTH), f32, 0.9, 0.999)
    return {
        "x": nrm(ks[0], (BATCH, SEQ, D_MODEL), 1.0),
        "p": nrm(ks[1], (DEPTH, BATCH, SEQ, PLE_DIM), 1.0),
        "norm_mix_pre": gain(ks[2], (DEPTH, D_MODEL)),
        "norm_mix_post": gain(ks[3], (DEPTH, D_MODEL)),
        "norm_mlp_pre": gain(ks[4], (DEPTH, D_MODEL)),
        "norm_mlp_post": gain(ks[5], (DEPTH, D_MODEL)),
        "w_in": nrm(ks[6], (DEPTH, D_MODEL, IN_DIM), D_MODEL ** -0.5),
        "conv_w": nrm(ks[7], (DEPTH, CONV_WIDTH, LRU_WIDTH), CONV_WIDTH ** -0.5),
        "conv_b": nrm(ks[8], (DEPTH, LRU_WIDTH), 0.02),
        "lru_wa": nrm(ks[9], (DEPTH, LRU_BLOCKS, LRU_BLOCK_DIM, LRU_BLOCK_DIM), LRU_BLOCK_DIM ** -0.5),
        "lru_ba": nrm(ks[11], (DEPTH, LRU_BLOCKS, LRU_BLOCK_DIM), 0.02),
        "lru_wx": nrm(ks[12], (DEPTH, LRU_BLOCKS, LRU_BLOCK_DIM, LRU_BLOCK_DIM), LRU_BLOCK_DIM ** -0.5),
        "lru_bx": nrm(ks[13], (DEPTH, LRU_BLOCKS, LRU_BLOCK_DIM), 0.02),
        "lru_lambda": jnp.log(a0 / (1.0 - a0)),
        "cmp_pe_k": nrm(ks[14], (DEPTH, CMP_LEN, HEAD_DIM), 0.1),
        "cmp_w1_k": nrm(ks[15], (DEPTH, CMP_LEN * HEAD_DIM, CMP_HIDDEN), (CMP_LEN * HEAD_DIM) ** -0.5),
        "cmp_w2_k": nrm(ks[16], (DEPTH, CMP_HIDDEN, HEAD_DIM), CMP_HIDDEN ** -0.5),
        "cmp_pe_v": nrm(ks[17], (DEPTH, CMP_LEN, HEAD_DIM), 0.1),
        "cmp_w1_v": nrm(ks[18], (DEPTH, CMP_LEN * HEAD_DIM, CMP_HIDDEN), (CMP_LEN * HEAD_DIM) ** -0.5),
        "cmp_w2_v": nrm(ks[19], (DEPTH, CMP_HIDDEN, HEAD_DIM), CMP_HIDDEN ** -0.5),
        "rel_bias": nrm(ks[20], (N_BUCKETS, N_HEADS), 0.1),
        "gnorm_lru": gain(ks[21], (DEPTH, LRU_WIDTH)),
        "gnorm_nsa": gain(ks[22], (DEPTH, N_HEADS * HEAD_DIM)),
        "w_out": nrm(ks[23], (DEPTH, MIX_WIDTH, D_MODEL), MIX_WIDTH ** -0.5),
        "mlp_w1": nrm(ks[24], (DEPTH, D_MODEL, D_FF), D_MODEL ** -0.5),
        "mlp_w2": nrm(ks[25], (DEPTH, D_FF, D_MODEL), D_FF ** -0.5),
        "ple_gate": nrm(ks[26], (DEPTH, D_MODEL, D_MODEL), D_MODEL ** -0.5),
        "ple_proj": nrm(ks[27], (DEPTH, PLE_DIM, D_MODEL), PLE_DIM ** -0.5),
    }


def reference(x, p, norm_mix_pre, norm_mix_post, norm_mlp_pre, norm_mlp_post, w_in,
              conv_w, conv_b, lru_wa, lru_ba, lru_wx, lru_bx, lru_lambda,
              cmp_pe_k, cmp_w1_k, cmp_w2_k, cmp_pe_v, cmp_w1_v, cmp_w2_v, rel_bias,
              gnorm_lru, gnorm_nsa, w_out, mlp_w1, mlp_w2, ple_gate, ple_proj):
    h = x
    for i in range(DEPTH):
        a = rms_norm(h, norm_mix_pre[i])
        z = a @ w_in[i]
        u, g_lru, q, kc, vc, ksel, vsel, kw, vw, gts = jnp.split(z, SPLIT_POINTS, axis=-1)
        y_lru = rglru_mixer(u, g_lru, conv_w[i], conv_b[i], lru_wa[i], lru_ba[i],
                            lru_wx[i], lru_bx[i], lru_lambda[i])
        y_nsa = nsa_mixer(q, kc, vc, ksel, vsel, kw, vw, gts,
                          cmp_pe_k[i], cmp_w1_k[i], cmp_w2_k[i],
                          cmp_pe_v[i], cmp_w1_v[i], cmp_w2_v[i], rel_bias)
        y = jnp.concatenate([rms_norm(y_lru, gnorm_lru[i]), rms_norm(y_nsa, gnorm_nsa[i])], axis=-1)
        h = h + rms_norm(y @ w_out[i], norm_mix_post[i])
        f = jnp.square(jax.nn.relu(rms_norm(h, norm_mlp_pre[i]) @ mlp_w1[i])) @ mlp_w2[i]
        h = h + rms_norm(f, norm_mlp_post[i])
        h = h + jax.nn.sigmoid(h @ ple_gate[i]) * (p[i] @ ple_proj[i])
    return h
```

```cpp
#include <hip/hip_runtime.h>
#include <cstdio>
#include <cstdint>

constexpr int BATCH = 16, SEQ = 2048, DM = 2048, MTOK = BATCH * SEQ;
constexpr int IN_DIM = 4656, ZP = 4864;
constexpr int C_U = 0, C_GL = 1024, C_Q = 2048, C_KC = 3072, C_VC = 3328, C_KS = 3584, C_VS = 3840, C_KW = 4096, C_VW = 4352, C_GT = 4608;
constexpr int DFF = 8192, PLE = 256, LRUW = 1024, NHEAD = 16, HD = 64, NKV = 4;
constexpr int NCMP = 127, NCMP_P = 128, CMP_K = 2048, CMP_H = 256;
constexpr float NORM_EPS = 1e-6f;
constexpr float LOG2E = 1.4426950408889634f;

namespace pg8 {
#define PG8_LAS __attribute__((address_space(3)))
typedef unsigned short bf16_t;
typedef short bf16x8 __attribute__((ext_vector_type(8)));
typedef float f32x4 __attribute__((ext_vector_type(4)));
typedef unsigned u32x4 __attribute__((ext_vector_type(4)));
constexpr int BM = 256, BK = 64, HALF = 128, HTB = HALF * BK * 2  , STAGE_BYTES = 8 * HTB, NXCD = 8, WGM = 8;

__host__ __device__ __forceinline__ int lds_byte(int r, int c) { const int st = (r >> 4) * 2 + (c >> 5), rr = r & 15, cc = c & 31, ob = rr * 64 + cc * 2; return st * 1024 + (ob ^ (((ob >> 9) & 1) << 5)); }
__host__ __device__ __forceinline__ void stage_rc(int b, int& R, int& C) { const int st = b / 1024, sb = b % 1024, swz = sb ^ (((sb >> 9) & 1) << 5); R = (st >> 1) * 16 + swz / 64; C = (st & 1) * 32 + (swz % 64) / 2; }
__host__ __device__ __forceinline__ int perm32(int rho) { const int n = rho >> 4, i = rho & 15; return 8 * (i >> 2) + 4 * n + (i & 3); }

struct Unit { int pm, pn; };
struct Gemm { const bf16_t* A; const bf16_t* Bt; int M, N, K; };

struct StaticOrder {
    int nM, nN, nwg, G, c;
    __host__ __device__ void init(int M, int N, int G_, int c_) { nM = M / BM; nN = N / BM; nwg = nM * nN; G = G_; c = c_; }
    __host__ __device__ bool next(int i, Unit& u) const {
        const long L = (long)i * G + c; if (L >= nwg) return false;
        int wgid = (int)L; { const int q = nwg / NXCD, r = nwg % NXCD, xcd = wgid % NXCD, off = wgid / NXCD; wgid = (xcd < r ? xcd * (q + 1) : r * (q + 1) + (xcd - r) * q) + off; }
        const int nig = WGM * nN, gid = wgid / nig, fm = gid * WGM, gsz = (nM - fm) < WGM ? (nM - fm) : WGM;
        u.pm = fm + ((wgid % nig) % gsz); u.pn = (wgid % nig) / gsz; return true;
    }
    __device__ __forceinline__ void a_ready(const Unit&) const {}
    __device__ __forceinline__ void done(const Unit&) const {}
};

__device__ __forceinline__ unsigned cvt_pk_bf16(float lo, float hi) { unsigned r; asm volatile("v_cvt_pk_bf16_f32 %0, %1, %2" : "=v"(r) : "v"(lo), "v"(hi)); return r; }
struct AMapPlain {
    __device__ static __forceinline__ int lda(const Gemm& g) { return g.K; }
    __device__ static __forceinline__ size_t kstep(const Gemm&) { return (size_t)(BK * 2); }
    __device__ static __forceinline__ size_t hstep(const Gemm& g) { return (size_t)HALF * g.K * 2; }
    __device__ static __forceinline__ const char* base(const Gemm& g, int pm) { return (const char*)g.A + (size_t)pm * 2 * HALF * g.K * 2; }
};
struct AMapCmp {
    __device__ static __forceinline__ int lda(const Gemm&) { return 16 * ZP; }
    __device__ static __forceinline__ size_t kstep(const Gemm&) { return (size_t)ZP * 2; }
    __device__ static __forceinline__ size_t hstep(const Gemm&) { return (size_t)128; }
    __device__ static __forceinline__ const char* base(const Gemm& g, int pm) { return (const char*)g.A + ((size_t)(pm >> 1) * SEQ * ZP + (size_t)(pm & 1) * 128) * 2; }
};

__device__ __forceinline__ float gelu_tanh(float v) {
    const float e = __builtin_amdgcn_exp2f(-2.302208198f * v * (1.0f + 0.044715f * v * v));
    return v * __builtin_amdgcn_rcpf(1.0f + e);
}
template <int ACT> struct EpiAct {
    static constexpr bool PERM = true, AFTER_DRAIN = false;
    bf16_t* O; int ldc; const float* bias;
    __device__ __forceinline__ void operator()(const f32x4 (&acc)[2][2][4][2], const Unit& u, int wr, int wc, int fr, int fq) const {
        const int row0 = u.pm * BM + wr * 64 + fr; const int col0 = u.pn * BM + wc * 32 + 8 * fq;
        f32x4 bv[2][2];
#pragma unroll
        for (int bj = 0; bj < 2; ++bj)
#pragma unroll
            for (int n = 0; n < 2; ++n) bv[bj][n] = bias ? *(const f32x4*)(bias + col0 + bj * HALF + 4 * n) : (f32x4){0.f, 0.f, 0.f, 0.f};
#pragma unroll
        for (int ai = 0; ai < 2; ++ai)
#pragma unroll
            for (int m = 0; m < 4; ++m) { bf16_t* rowp = O + (size_t)(row0 + ai * HALF + m * 16) * ldc + col0;
#pragma unroll
                for (int bj = 0; bj < 2; ++bj) { f32x4 v0 = acc[ai][bj][m][0] + bv[bj][0], v1 = acc[ai][bj][m][1] + bv[bj][1];
                    if (ACT == 2) {
#pragma unroll
                        for (int e = 0; e < 4; ++e) { v0[e] = gelu_tanh(v0[e]); v1[e] = gelu_tanh(v1[e]); } }
                    if (ACT == 3) {
#pragma unroll
                        for (int e = 0; e < 4; ++e) { const float a = fmaxf(v0[e], 0.f), b = fmaxf(v1[e], 0.f); v0[e] = a * a; v1[e] = b * b; } }
                    u32x4 w; w.x = cvt_pk_bf16(v0[0], v0[1]); w.y = cvt_pk_bf16(v0[2], v0[3]); w.z = cvt_pk_bf16(v1[0], v1[1]); w.w = cvt_pk_bf16(v1[2], v1[3]);
                    *(u32x4*)(rowp + bj * HALF) = w; } }
    }
};
struct EpiSsq {
    static constexpr bool PERM = true, AFTER_DRAIN = false;
    bf16_t* O; int ldc; float* ssq;
    __device__ __forceinline__ void operator()(const f32x4 (&acc)[2][2][4][2], const Unit& u, int wr, int wc, int fr, int fq) const {
        const int row0 = u.pm * BM + wr * 64 + fr; const int col0 = u.pn * BM + wc * 32 + 8 * fq;
#pragma unroll
        for (int ai = 0; ai < 2; ++ai)
#pragma unroll
            for (int m = 0; m < 4; ++m) { const int row = row0 + ai * HALF + m * 16; bf16_t* rowp = O + (size_t)row * ldc + col0; float s = 0.f;
#pragma unroll
                for (int bj = 0; bj < 2; ++bj) { const f32x4 v0 = acc[ai][bj][m][0], v1 = acc[ai][bj][m][1];
                    s += (v0[0] * v0[0] + v0[1] * v0[1]) + (v0[2] * v0[2] + v0[3] * v0[3]); s += (v1[0] * v1[0] + v1[1] * v1[1]) + (v1[2] * v1[2] + v1[3] * v1[3]);
                    u32x4 w; w.x = cvt_pk_bf16(v0[0], v0[1]); w.y = cvt_pk_bf16(v0[2], v0[3]); w.z = cvt_pk_bf16(v1[0], v1[1]); w.w = cvt_pk_bf16(v1[2], v1[3]);
                    *(u32x4*)(rowp + bj * HALF) = w; }
                s += __shfl_xor(s, 16); s += __shfl_xor(s, 32);
                if (fq == 0) ssq[(size_t)row * 32 + u.pn * 4 + wc] = s; }
    }
};
struct EpiGate {
    static constexpr bool PERM = true, AFTER_DRAIN = false;
    float* out; const bf16_t* pp; int ldc;
    __device__ __forceinline__ void operator()(const f32x4 (&acc)[2][2][4][2], const Unit& u, int wr, int wc, int fr, int fq) const {
        const int row0 = u.pm * BM + wr * 64 + fr; const int col0 = u.pn * BM + wc * 32 + 8 * fq;
#pragma unroll
        for (int ai = 0; ai < 2; ++ai)
#pragma unroll
            for (int m = 0; m < 4; ++m) { const size_t ro = (size_t)(row0 + ai * HALF + m * 16) * ldc + col0;
#pragma unroll
                for (int bj = 0; bj < 2; ++bj) { const f32x4 v0 = acc[ai][bj][m][0], v1 = acc[ai][bj][m][1];
                    const u32x4 pw = *(const u32x4*)(pp + ro + bj * HALF); float* op = out + ro + bj * HALF;
                    f32x4 h0 = *(const f32x4*)op, h1 = *(const f32x4*)(op + 4);
                    const unsigned pu[4] = {pw.x, pw.y, pw.z, pw.w};
#pragma unroll
                    for (int e = 0; e < 4; ++e) { const float p0 = __uint_as_float((e & 1) ? (pu[e >> 1] & 0xffff0000u) : (pu[e >> 1] << 16));
                        const float p1 = __uint_as_float((e & 1) ? (pu[2 + (e >> 1)] & 0xffff0000u) : (pu[2 + (e >> 1)] << 16));
                        h0[e] += __builtin_amdgcn_rcpf(1.0f + __builtin_amdgcn_exp2f(-LOG2E * v0[e])) * p0;
                        h1[e] += __builtin_amdgcn_rcpf(1.0f + __builtin_amdgcn_exp2f(-LOG2E * v1[e])) * p1; }
                    *(f32x4*)op = h0; *(f32x4*)(op + 4) = h1; } }
    }
};
template <class Epi, class Sched, class AM, bool ALIGN_EPI = false, bool SP2 = false>
__device__ __forceinline__ void gemm_phase(PG8_LAS unsigned char* lds, const Gemm g, const Sched& S, const Epi& E) {
    const int tid = threadIdx.x, wid = __builtin_amdgcn_readfirstlane(tid >> 6), lane = tid & 63, wr = wid >> 2, wc = wid & 3, fr = lane & 15, fq = lane >> 4;
    const int K = g.K, nt = K / BK;
    unsigned voffA[2], voffB[2];
#pragma unroll
    for (int i = 0; i < 2; ++i) { int R, C; stage_rc(tid * 16 + i * 8192, R, C); const int Rb = Epi::PERM ? ((R & ~31) + perm32(R & 31)) : R;
        voffA[i] = (unsigned)(R * AM::lda(g) + C) * 2u; voffB[i] = (unsigned)(Rb * K + C) * 2u; }
    const size_t kstep = (size_t)(BK * 2); const size_t kstepA = AM::kstep(g), hstepA = AM::hstep(g);
    const size_t hstep = (size_t)HALF * K * 2;
    const size_t tstep = 2 * hstep;
    const unsigned ldsw = (unsigned)wid * 1024u;
    const int aoff = lds_byte(wr * 64 + fr, fq * 8), boff = lds_byte(wc * 32 + fr, fq * 8);
#define PG8_SA(b, h) (((b) * 2 + (h)) * HTB)
#define PG8_SB(b, h) ((4 + (b) * 2 + (h)) * HTB)
#define PG8_STAGE(bufoff, gbase, voff) do { _Pragma("unroll") for (int _i = 0; _i < 2; ++_i) \
        __builtin_amdgcn_global_load_lds((const unsigned*)((const char*)(gbase) + (voff)[_i]), (PG8_LAS unsigned*)(lds + (bufoff) + ldsw + _i * 8192), 16, 0, 0); } while (0)
#define PG8_LDA(dst, b, h) do { _Pragma("unroll") for (int m = 0; m < 4; ++m) _Pragma("unroll") for (int k = 0; k < 2; ++k) dst[m][k] = *(const PG8_LAS bf16x8*)(lds + PG8_SA(b, h) + aoff + m * 2048 + k * 1024); } while (0)
#define PG8_LDB(dst, b, h) do { _Pragma("unroll") for (int n = 0; n < 2; ++n) _Pragma("unroll") for (int k = 0; k < 2; ++k) dst[n][k] = *(const PG8_LAS bf16x8*)(lds + PG8_SB(b, h) + boff + n * 2048 + k * 1024); } while (0)
#define PG8_MMA(ai, bj, At, Bt) do { __builtin_amdgcn_s_setprio(1); _Pragma("unroll") for (int m = 0; m < 4; ++m) _Pragma("unroll") for (int n = 0; n < 2; ++n) _Pragma("unroll") for (int k = 0; k < 2; ++k) \
        acc[ai][bj][m][n] = __builtin_amdgcn_mfma_f32_16x16x32_bf16(Bt[n][k], At[m][k], acc[ai][bj][m][n], 0, 0, 0); __builtin_amdgcn_s_setprio(0); } while (0)
#define PG8_WAIT_V(n) asm volatile("s_waitcnt vmcnt(" #n ")" ::: "memory")
#define PG8_WAIT_L(n) asm volatile("s_waitcnt lgkmcnt(" #n ")" ::: "memory")
#define PG8_BAR __builtin_amdgcn_s_barrier()
#define PG8_SCHED __builtin_amdgcn_sched_barrier(0)
    Unit cur, nxt; int ui = 0;
    if (!S.next(0, cur)) return;
    f32x4 acc[2][2][4][2];
#pragma unroll
    for (int a = 0; a < 2; ++a)
#pragma unroll
        for (int b = 0; b < 2; ++b)
#pragma unroll
            for (int m = 0; m < 4; ++m)
#pragma unroll
                for (int n = 0; n < 2; ++n) acc[a][b][m][n] = (f32x4){0.f, 0.f, 0.f, 0.f};
    bf16x8 At[4][2], B0[2][2], B1[2][2];
    const char* cA = AM::base(g, cur.pm); const char* cB = (const char*)g.Bt + (size_t)cur.pn * tstep;
    S.a_ready(cur);
    if constexpr (SP2) {
        PG8_STAGE(PG8_SB(0, 0), cB, voffB); PG8_STAGE(PG8_SB(0, 1), cB + hstep, voffB); PG8_STAGE(PG8_SA(0, 0), cA, voffA); PG8_STAGE(PG8_SA(0, 1), cA + hstepA, voffA);
        if (wr == 1) PG8_BAR;
        PG8_WAIT_V(2); PG8_BAR;
        PG8_STAGE(PG8_SB(1, 0), cB + kstep, voffB); PG8_STAGE(PG8_SA(1, 0), cA + kstepA, voffA); PG8_STAGE(PG8_SB(1, 1), cB + hstep + kstep, voffB);
        PG8_WAIT_V(6); PG8_BAR;
    } else {
        PG8_STAGE(PG8_SB(0, 0), cB, voffB); PG8_STAGE(PG8_SA(0, 0), cA, voffA); PG8_STAGE(PG8_SB(0, 1), cB + hstep, voffB); PG8_STAGE(PG8_SA(0, 1), cA + hstepA, voffA);
        if (wr == 1) PG8_BAR;
        PG8_WAIT_V(4); PG8_BAR;
        PG8_STAGE(PG8_SB(1, 0), cB + kstep, voffB); PG8_STAGE(PG8_SA(1, 0), cA + kstepA, voffA); PG8_STAGE(PG8_SB(1, 1), cB + hstep + kstep, voffB);
        PG8_WAIT_V(6); PG8_BAR;
    }
    for (;;) {
        const bool has_next = S.next(ui + 1, nxt);
        const char* nA = has_next ? AM::base(g, nxt.pm) : cA; const char* nB = has_next ? (const char*)g.Bt + (size_t)nxt.pn * tstep : cB;
        for (int t = 0; t < nt; t += 2) {
            const bool last = (t == nt - 2);
            const char* a1 = cA + (size_t)(t + 1) * kstepA;
            const char* a2 = last ? nA : cA + (size_t)(t + 2) * kstepA; const char* b2 = last ? nB : cB + (size_t)(t + 2) * kstep;
            const char* a3 = a2 + kstepA; const char* b3 = b2 + kstep;
            if (last && has_next) S.a_ready(nxt);
            if constexpr (SP2) {
            PG8_LDB(B0, 0, 0); PG8_LDB(B1, 0, 1); PG8_SCHED; PG8_LDA(At, 0, 0); PG8_STAGE(PG8_SA(1, 1), a1 + hstepA, voffA);
            PG8_WAIT_V(8); PG8_WAIT_L(0); PG8_BAR; PG8_MMA(0, 0, At, B0); PG8_MMA(0, 1, At, B1); PG8_BAR; PG8_SCHED;
            PG8_LDA(At, 0, 1); PG8_STAGE(PG8_SB(0, 0), b2, voffB); PG8_STAGE(PG8_SB(0, 1), b2 + hstep, voffB); PG8_STAGE(PG8_SA(0, 0), a2, voffA);
            PG8_WAIT_V(8); PG8_WAIT_L(0); PG8_BAR; PG8_MMA(1, 0, At, B0); PG8_MMA(1, 1, At, B1); PG8_BAR; PG8_SCHED;
            PG8_LDB(B0, 1, 0); PG8_LDB(B1, 1, 1); PG8_SCHED; PG8_LDA(At, 1, 0); PG8_STAGE(PG8_SA(0, 1), a2 + hstepA, voffA);
            PG8_WAIT_V(8); PG8_WAIT_L(0); PG8_BAR; PG8_MMA(0, 0, At, B0); PG8_MMA(0, 1, At, B1); PG8_BAR; PG8_SCHED;
            PG8_LDA(At, 1, 1); PG8_STAGE(PG8_SB(1, 0), b3, voffB); PG8_STAGE(PG8_SB(1, 1), b3 + hstep, voffB); PG8_STAGE(PG8_SA(1, 0), a3, voffA);
            PG8_WAIT_V(8); PG8_WAIT_L(0); PG8_BAR; PG8_MMA(1, 0, At, B0); PG8_MMA(1, 1, At, B1); PG8_BAR; PG8_SCHED;
            } else {
            PG8_LDB(B0, 0, 0); PG8_SCHED; PG8_LDA(At, 0, 0); PG8_STAGE(PG8_SA(1, 1), a1 + hstepA, voffA);
            PG8_WAIT_L(8); PG8_BAR; PG8_WAIT_L(0); PG8_MMA(0, 0, At, B0); PG8_BAR; PG8_SCHED;
            PG8_LDB(B1, 0, 1); PG8_STAGE(PG8_SB(0, 0), b2, voffB);
            PG8_BAR; PG8_WAIT_L(0); PG8_MMA(0, 1, At, B1); PG8_BAR;
            PG8_LDA(At, 0, 1); PG8_STAGE(PG8_SA(0, 0), a2, voffA);
            PG8_BAR; PG8_WAIT_L(0); PG8_MMA(1, 0, At, B0); PG8_BAR; PG8_SCHED;
            PG8_STAGE(PG8_SB(0, 1), b2 + hstep, voffB);
            PG8_WAIT_V(6); PG8_BAR; PG8_MMA(1, 1, At, B1); PG8_BAR;
            PG8_LDB(B0, 1, 0); PG8_SCHED; PG8_LDA(At, 1, 0); PG8_STAGE(PG8_SA(0, 1), a2 + hstepA, voffA);
            PG8_WAIT_L(8); PG8_BAR; PG8_WAIT_L(0); PG8_MMA(0, 0, At, B0); PG8_BAR; PG8_SCHED;
            PG8_LDB(B1, 1, 1); PG8_STAGE(PG8_SB(1, 0), b3, voffB);
            PG8_BAR; PG8_WAIT_L(0); PG8_MMA(0, 1, At, B1); PG8_BAR;
            PG8_LDA(At, 1, 1); PG8_STAGE(PG8_SA(1, 0), a3, voffA);
            PG8_BAR; PG8_WAIT_L(0); PG8_MMA(1, 0, At, B0); PG8_BAR; PG8_SCHED;
            PG8_STAGE(PG8_SB(1, 1), b3 + hstep, voffB);
            PG8_WAIT_V(6); PG8_BAR; PG8_MMA(1, 1, At, B1); PG8_BAR;
            }
        }
        if constexpr (ALIGN_EPI) { if (wr == 0) PG8_BAR; }
        if constexpr (!Epi::AFTER_DRAIN) { E(acc, cur, wr, wc, fr, fq); S.done(cur); }
        if (!has_next) break;
#pragma unroll
        for (int a = 0; a < 2; ++a)
#pragma unroll
            for (int b = 0; b < 2; ++b)
#pragma unroll
                for (int m = 0; m < 4; ++m)
#pragma unroll
                    for (int n = 0; n < 2; ++n) acc[a][b][m][n] = (f32x4){0.f, 0.f, 0.f, 0.f};
        cur = nxt; cA = nA; cB = nB; ++ui;
        if constexpr (ALIGN_EPI) { if (wr == 1) PG8_BAR; }
    }
    PG8_WAIT_V(0);
    if constexpr (!ALIGN_EPI) { if (wr == 0) PG8_BAR; }
    PG8_BAR;
    if constexpr (Epi::AFTER_DRAIN) { E.fused(acc, cur, wr, wc, fr, fq, lds, wid, lane); S.done(cur); }
#undef PG8_SA
#undef PG8_SB
#undef PG8_STAGE
#undef PG8_LDA
#undef PG8_LDB
#undef PG8_MMA
#undef PG8_WAIT_V
#undef PG8_WAIT_L
#undef PG8_BAR
#undef PG8_SCHED
}
}
constexpr size_t MiB = 1u << 20;
constexpr size_t WS_CTL = 0, CTL_ZERO_BYTES = 1 * MiB;
constexpr size_t WS_WIN = 2 * MiB, WS_WOUT = 21 * MiB, WS_W1 = 29 * MiB, WS_W2 = 61 * MiB, WS_WG = 93 * MiB, WS_WP = 101 * MiB, WS_CW1K = 102 * MiB, WS_CW1V = 103 * MiB;
constexpr size_t WS_MISC = 104 * MiB;
constexpr size_t WS_PB = 105 * MiB;
constexpr size_t WS_HID = 121 * MiB;
constexpr size_t WS_KCVC = 129 * MiB;
constexpr size_t WS_SSL = 131 * MiB, WS_SSN = 133 * MiB;
constexpr size_t WS_SSQ = 134 * MiB;
constexpr size_t WS_A = 140 * MiB;
constexpr size_t WS_Z = 268 * MiB;
constexpr size_t WS_Y = 573 * MiB;
constexpr size_t WS_T = 701 * MiB;
constexpr size_t WS_HID2 = 268 * MiB;
constexpr size_t WS_F = 780 * MiB;
constexpr size_t WS_PP = 268 * MiB;
constexpr size_t WS_END = 908 * MiB;
constexpr int CW_TMO = 0, CW_CODE = 1, CW_BAR = 4096;

constexpr int RING_OFF = 0, RING_BYTES = 131072;
constexpr int LDSCTL_OFF = RING_BYTES, MISC_OFF = LDSCTL_OFF + 320;
constexpr int LDS_BYTES = 147456;
constexpr int NWAVES = 8;

#define GAS __attribute__((address_space(1)))
#define LAS __attribute__((address_space(3)))
typedef unsigned short bf16;
typedef unsigned v4u __attribute__((ext_vector_type(4)));
typedef unsigned v2u __attribute__((ext_vector_type(2)));
typedef float f32x4 __attribute__((ext_vector_type(4)));
typedef float f32x16 __attribute__((ext_vector_type(16)));
typedef short bf16x8 __attribute__((ext_vector_type(8)));
typedef short s16x4 __attribute__((ext_vector_type(4)));
typedef GAS unsigned gu32;
#define RLX_AGENT __ATOMIC_RELAXED, __HIP_MEMORY_SCOPE_AGENT
#define LDS_WAIT() asm volatile("s_waitcnt lgkmcnt(0)" ::: "memory")
#define VM_WAIT() asm volatile("s_waitcnt vmcnt(0)" ::: "memory")
__device__ __forceinline__ unsigned f2bf(float f) { unsigned u = __builtin_bit_cast(unsigned, f); return (u + 0x7fffu + ((u >> 16) & 1u)) >> 16; }
__device__ __forceinline__ unsigned pk2(float lo, float hi) { return f2bf(lo) | (f2bf(hi) << 16); }
__device__ __forceinline__ float bf2f(unsigned b) { return __uint_as_float(b << 16); }
__device__ __forceinline__ float bflo(unsigned w) { return __uint_as_float(w << 16); }
__device__ __forceinline__ float bfhi(unsigned w) { return __uint_as_float(w & 0xffff0000u); }
__device__ __forceinline__ float wave_sum(float v) {
#pragma unroll
    for (int o = 1; o < 64; o <<= 1) v += __shfl_xor(v, o);
    return v;
}
__device__ __forceinline__ float sigmoidf_(float v) { return __builtin_amdgcn_rcpf(1.0f + __builtin_amdgcn_exp2f(-LOG2E * v)); }
#define XB_TMO      128
#define XB_XCNT(j)  (256  + 64 * (j))
#define XB_XSUB(j)  (1280 + 64 * (j))
#define XB_XGEN(j)  (2304 + 64 * (j))
#define XB_TOP      3328
#define XB_TOPGEN   3392
#define XCD_BAR_WORDS 3456
#define XB_SPIN_CAP (1u << 18)

__device__ __forceinline__ unsigned xb_ld(unsigned* p)              { return __hip_atomic_load(p, __ATOMIC_RELAXED, __HIP_MEMORY_SCOPE_AGENT); }
__device__ __forceinline__ unsigned xb_add(unsigned* p, unsigned v) { return __hip_atomic_fetch_add(p, v, __ATOMIC_RELAXED, __HIP_MEMORY_SCOPE_AGENT); }
__device__ __forceinline__ unsigned xb_xcc_id() { return (unsigned)__builtin_amdgcn_s_getreg((3 << 11) | 20) & 0xFu; }
#define XB_SPIN(cond, bar) do { unsigned _sp = 0; while (cond) { __builtin_amdgcn_s_sleep(1); \
    if ((++_sp & 255u) == 0u) { if (xb_ld(&(bar)[XB_TMO])) break; if (_sp > XB_SPIN_CAP) { atomicAdd(&(bar)[XB_TMO], 1u); break; } } } } while (0)

struct XcdBarrier {
    unsigned* bar; unsigned x;
    volatile LAS unsigned* st;
};

__device__ __forceinline__ XcdBarrier xcd_barrier_post(unsigned* bar, volatile LAS unsigned* st) {
    XcdBarrier b; b.bar = bar; b.x = xb_xcc_id(); b.st = st;
    if (threadIdx.x == 0) (void)xb_add(&bar[XB_XCNT(b.x)], 1u);
    return b;
}
__device__ __forceinline__ void xcd_barrier_complete(unsigned* bar, unsigned x, unsigned& nloc, unsigned& nx) {
    const unsigned G = gridDim.x * gridDim.y * gridDim.z;
    unsigned sum, cnt, mine, sp = 0u;
    for (;;) {
        sum = 0u; cnt = 0u; mine = 0u;
#pragma unroll
        for (unsigned j = 0; j < 16; ++j) { const unsigned c = xb_ld(&bar[XB_XCNT(j)]); sum += c; cnt += (c > 0u) ? 1u : 0u; mine = (j == x) ? c : mine; }
        if (sum == G) break;
        __builtin_amdgcn_s_sleep(1);
        if ((++sp & 255u) == 0u) { if (xb_ld(&bar[XB_TMO])) break; if (sp > XB_SPIN_CAP) { atomicAdd(&bar[XB_TMO], 1u); break; } }
    }
    nloc = mine > 0u ? mine : 1u; nx = cnt > 0u ? cnt : 1u;
}

__device__ __forceinline__ void xcd_barrier(const XcdBarrier& b) {
    asm volatile("s_waitcnt vmcnt(0)" ::: "memory");
    __syncthreads();
    if (threadIdx.x == 0) {
        unsigned* bar = b.bar;
        __builtin_amdgcn_s_waitcnt(0);
        unsigned nloc = b.st[0], nx = b.st[1];
        if (nloc == 0u) { xcd_barrier_complete(bar, b.x, nloc, nx); b.st[0] = nloc; b.st[1] = nx; }
        const unsigned old = xb_add(&bar[XB_XSUB(b.x)], 1u);
        const unsigned gen = old / nloc;
        if (old + 1u == (gen + 1u) * nloc) {
            __builtin_amdgcn_fence(__ATOMIC_RELEASE, "agent");
            asm volatile("s_waitcnt vmcnt(0)" ::: "memory");
            const unsigned og = xb_add(&bar[XB_TOP], 1u);
            const unsigned tg = og / nx;
            if (og + 1u == (tg + 1u) * nx) xb_add(&bar[XB_TOPGEN], 1u);
            else XB_SPIN(xb_ld(&bar[XB_TOPGEN]) == tg, bar);
            __builtin_amdgcn_fence(__ATOMIC_ACQUIRE, "agent");
            xb_add(&bar[XB_XGEN(b.x)], 1u);
            asm volatile("s_waitcnt vmcnt(0)" ::: "memory");
        } else {
            XB_SPIN(xb_ld(&bar[XB_XGEN(b.x)]) == gen, bar);
            __builtin_amdgcn_fence(__ATOMIC_ACQUIRE, "agent");
            asm volatile("s_waitcnt vmcnt(0)" ::: "memory");
        }
    }
    __syncthreads();
}

namespace nsa {
constexpr int KPB = 144, VPB = 192;
constexpr int KBUF = 64 * KPB, VBUF = 64 * VPB;
constexpr int L_K = 0, L_V = 2 * KBUF, L_BIAS = L_V + 2 * VBUF, L_PSUM = L_BIAS + 2048, L_IMPV = L_PSUM + 128 * 65 * 4, L_SEL = L_IMPV + 64 * 32 * 4, L_SSQ = L_SEL + 256, L_END = L_SSQ + 1024;
static_assert(L_END <= RING_BYTES, "nsa LDS");
constexpr float NEG = -1.0e30f;
constexpr float C1 = 0.125f * LOG2E;
__device__ __forceinline__ int crow(int i, int hh) { return (i & 3) + 8 * (i >> 2) + 4 * hh; }
__device__ __forceinline__ int t5_bucket(int n) {
    if (n < 16) return n;
    int b = 16;
    b += (n >= 19); b += (n >= 21); b += (n >= 24); b += (n >= 27); b += (n >= 31); b += (n >= 35); b += (n >= 40); b += (n >= 46);
    b += (n >= 52); b += (n >= 59); b += (n >= 67); b += (n >= 77); b += (n >= 87); b += (n >= 99); b += (n >= 113);
    return b;
}
__device__ __forceinline__ s16x4 trr(const LAS char* p) { return __builtin_bit_cast(s16x4, __builtin_amdgcn_ds_read_tr16_b64_v4i16((LAS s16x4*)p)); }
__device__ __forceinline__ unsigned cvtpk(float lo, float hi) { typedef float f2 __attribute__((ext_vector_type(2))); typedef __bf16 b2 __attribute__((ext_vector_type(2))); f2 v = {lo, hi}; b2 r = __builtin_convertvector(v, b2); return __builtin_bit_cast(unsigned, r); }
#define NSA_MFMA(a, b, c) __builtin_amdgcn_mfma_f32_32x32x16_bf16((a), (b), (c), 0, 0, 0)

__device__ __forceinline__ void qk_tile(f32x16& s0, f32x16& s1, const LAS char* kbuf, const bf16x8 (&qf)[4], int r32, int hh) {
    const LAS char* kb = kbuf + r32 * KPB + hh * 16;
    f32x16 z0 = {0.f,0.f,0.f,0.f,0.f,0.f,0.f,0.f,0.f,0.f,0.f,0.f,0.f,0.f,0.f,0.f}; s0 = z0; s1 = z0;
#pragma unroll
    for (int d0 = 0; d0 < 4; ++d0) {
        const bf16x8 a0 = *(const LAS bf16x8*)(kb + d0 * 32), a1 = *(const LAS bf16x8*)(kb + 32 * KPB + d0 * 32);
        s0 = NSA_MFMA(a0, qf[d0], s0); s1 = NSA_MFMA(a1, qf[d0], s1);
    }
}
__device__ __forceinline__ void pv_tile(f32x16 (&o)[2], const LAS char* vbuf, const f32x16& p0, const f32x16& p1, int lane) {
    const int hh = lane >> 5, q4 = (lane & 15) >> 2, pp = lane & 3, blk = (lane >> 4) & 1;
    const LAS char* vb = vbuf + (4 * hh + q4) * VPB + blk * 32 + pp * 8;
    bf16x8 pf[4];
    { v4u w;
      w.x = cvtpk(p0[0], p0[1]); w.y = cvtpk(p0[2], p0[3]); w.z = cvtpk(p0[4], p0[5]); w.w = cvtpk(p0[6], p0[7]); pf[0] = __builtin_bit_cast(bf16x8, w);
      w.x = cvtpk(p0[8], p0[9]); w.y = cvtpk(p0[10], p0[11]); w.z = cvtpk(p0[12], p0[13]); w.w = cvtpk(p0[14], p0[15]); pf[1] = __builtin_bit_cast(bf16x8, w);
      w.x = cvtpk(p1[0], p1[1]); w.y = cvtpk(p1[2], p1[3]); w.z = cvtpk(p1[4], p1[5]); w.w = cvtpk(p1[6], p1[7]); pf[2] = __builtin_bit_cast(bf16x8, w);
      w.x = cvtpk(p1[8], p1[9]); w.y = cvtpk(p1[10], p1[11]); w.z = cvtpk(p1[12], p1[13]); w.w = cvtpk(p1[14], p1[15]); pf[3] = __builtin_bit_cast(bf16x8, w); }
#pragma unroll
    for (int db = 0; db < 2; ++db)
#pragma unroll
        for (int s = 0; s < 4; ++s) {
            const s16x4 lo = trr(vb + (16 * s) * VPB + db * 64), hi = trr(vb + (16 * s + 8) * VPB + db * 64);
            const bf16x8 vf = {lo[0], lo[1], lo[2], lo[3], hi[0], hi[1], hi[2], hi[3]};
            o[db] = NSA_MFMA(vf, pf[s], o[db]);
        }
}
template <int KS, bool GEN> __device__ __forceinline__ void logits(f32x16& s0, f32x16& s1, int dq, int hi_excl, bool rowok, const LAS float* biasr, float bfar, int hh) {
    if (GEN) {
        const int dbase = dq - 4 * hh * KS;
#pragma unroll
        for (int i = 0; i < 16; ++i) {
            const int d0 = dbase - ((i & 3) + 8 * (i >> 2)) * KS, d1 = d0 - 32 * KS;
            const float b0 = biasr[min(max(d0, 0), 127)], b1 = biasr[min(max(d1, 0), 127)];
            const bool v0 = rowok && d0 >= 0 && d0 < hi_excl, v1 = rowok && d1 >= 0 && d1 < hi_excl;
            s0[i] = v0 ? fmaf(s0[i], C1, b0) : NEG; s1[i] = v1 ? fmaf(s1[i], C1, b1) : NEG;
        }
    } else {
        const float c = rowok ? C1 : 0.f, bo = rowok ? bfar : NEG;
#pragma unroll
        for (int i = 0; i < 16; ++i) { s0[i] = fmaf(s0[i], c, bo); s1[i] = fmaf(s1[i], c, bo); }
    }
}
__device__ __forceinline__ float max32(const f32x16& a, const f32x16& b) {
    float m = fmaxf(a[0], b[0]);
#pragma unroll
    for (int i = 1; i < 16; ++i) m = fmaxf(m, fmaxf(a[i], b[i]));
    return m;
}
__device__ __forceinline__ void softmax_pv(f32x16& s0, f32x16& s1, float& m, float& l, f32x16 (&o)[2], const LAS char* vbuf, int lane) {
    float mt = max32(s0, s1); mt = fmaxf(mt, __shfl_xor(mt, 32));
    const float mnew = fmaxf(m, mt), alpha = __builtin_amdgcn_exp2f(m - mnew); m = mnew;
    float ps = 0.f;
#pragma unroll
    for (int i = 0; i < 16; ++i) { s0[i] = __builtin_amdgcn_exp2f(s0[i] - mnew); s1[i] = __builtin_amdgcn_exp2f(s1[i] - mnew); ps += s0[i] + s1[i]; }
    l = l * alpha + ps;
#pragma unroll
    for (int i = 0; i < 16; ++i) { o[0][i] *= alpha; o[1][i] *= alpha; }
    pv_tile(o, vbuf, s0, s1, lane);
}

struct Tens { const bf16* z; const bf16* kcvc; const float* relb; bf16* y; float* ssn; };

template <int MODE> __device__ __forceinline__ void branch(LAS char* lds, const Tens& T, int b, int g, int qt, int tq, const bf16x8 (&qf)[4], const LAS float* biasr, float bfar,
                                                        unsigned selmask, float gate, f32x16 (&yacc)[2], int tid, int lane) {
    const int r32 = lane & 31, hh = lane >> 5;
    const int skey = tid >> 3, sch = tid & 7;
    const int kcol = (MODE == 1 ? C_KS : C_KW) + g * 64, vcol = (MODE == 1 ? C_VS : C_VW) + g * 64;
    const bf16* kbase = T.z + (size_t)(b * SEQ + skey) * ZP + kcol + sch * 8;
    const bf16* vbase = T.z + (size_t)(b * SEQ + skey) * ZP + vcol + sch * 8;
    const int kt_lo = (MODE == 1) ? 0 : (qt > 8 ? qt - 8 : 0);
    float m = NEG, l = 0.f; f32x16 o[2];
#pragma unroll
    for (int i = 0; i < 16; ++i) { o[0][i] = 0.f; o[1][i] = 0.f; }
    v4u kreg = *(const v4u*)(kbase + (size_t)kt_lo * 64 * ZP), vreg = *(const v4u*)(vbase + (size_t)kt_lo * 64 * ZP);
    int buf = 0;
    for (int kt = kt_lo; kt <= qt; ++kt) {
        *(LAS v4u*)(lds + L_K + buf * KBUF + skey * KPB + sch * 16) = kreg;
        *(LAS v4u*)(lds + L_V + buf * VBUF + skey * VPB + sch * 16) = vreg;
        __syncthreads();
        if (kt < qt) { kreg = *(const v4u*)(kbase + (size_t)(kt + 1) * 64 * ZP); vreg = *(const v4u*)(vbase + (size_t)(kt + 1) * 64 * ZP); }
        f32x16 s0, s1;
        qk_tile(s0, s1, lds + L_K + buf * KBUF, qf, r32, hh);
        const int dq = tq - kt * 64;
        const bool rowok = (MODE == 1) ? (((selmask >> kt) & 1u) != 0u) : true;
        const bool gen = (kt >= qt - 2) || (MODE == 2 && kt == qt - 8);
        if (gen) logits<1, true>(s0, s1, dq, (MODE == 2) ? 512 : 0x7fffffff, rowok, biasr, bfar, hh);
        else logits<1, false>(s0, s1, dq, 0, rowok, biasr, bfar, hh);
        softmax_pv(s0, s1, m, l, o, lds + L_V + buf * VBUF, lane);
        buf ^= 1;
    }
    l += __shfl_xor(l, 32);
    const float sc = gate * __builtin_amdgcn_rcpf(l);
#pragma unroll
    for (int i = 0; i < 16; ++i) { yacc[0][i] = fmaf(sc, o[0][i], yacc[0][i]); yacc[1][i] = fmaf(sc, o[1][i], yacc[1][i]); }
    __syncthreads();
}

__device__ __forceinline__ void unit(LAS char* lds, const Tens& T, int b, int g, int qt) {
    int tid = threadIdx.x; asm volatile("" : "+v"(tid));
    const int lane = tid & 63, wid = __builtin_amdgcn_readfirstlane(tid >> 6);
    const int r = wid >> 1, qh = wid & 1, r32 = lane & 31, hh = lane >> 5;
    const int t0 = qt * 64, tq = t0 + qh * 32 + r32, head = g * 4 + r;
    const size_t zrow = (size_t)(b * SEQ + tq) * ZP;
    LAS float* BIAS = (LAS float*)(lds + L_BIAS);
    LAS float* IMPV = (LAS float*)(lds + L_IMPV);
    LAS unsigned* SEL = (LAS unsigned*)(lds + L_SEL);
    LAS float* SSQ = (LAS float*)(lds + L_SSQ);
    { const int rr = tid >> 7, d = tid & 127; BIAS[tid] = T.relb[t5_bucket(d) * 16 + g * 4 + rr] * LOG2E; }
    bf16x8 qf[4];
#pragma unroll
    for (int d0 = 0; d0 < 4; ++d0) qf[d0] = *(const bf16x8*)(T.z + zrow + C_Q + head * 64 + d0 * 16 + hh * 8);
    const float g_c = sigmoidf_(bf2f(T.z[zrow + C_GT + head * 3 + 0])), g_s = sigmoidf_(bf2f(T.z[zrow + C_GT + head * 3 + 1])), g_w = sigmoidf_(bf2f(T.z[zrow + C_GT + head * 3 + 2]));
    f32x16 yacc[2];
#pragma unroll
    for (int i = 0; i < 16; ++i) { yacc[0][i] = 0.f; yacc[1][i] = 0.f; }
    const bool two = (qt >= 16);
    { const int skey = tid >> 3, sch = tid & 7;
      const bf16* kc = T.kcvc + (size_t)((b * 4 + g) * 128) * 64, *vc = kc + (size_t)64 * 128 * 64;
      const int nt = two ? 2 : 1;
      for (int tt = 0; tt < nt; ++tt) {
          *(LAS v4u*)(lds + L_K + tt * KBUF + skey * KPB + sch * 16) = *(const v4u*)(kc + (size_t)(tt * 64 + skey) * 64 + sch * 8);
          *(LAS v4u*)(lds + L_V + tt * VBUF + skey * VPB + sch * 16) = *(const v4u*)(vc + (size_t)(tt * 64 + skey) * 64 + sch * 8);
      } }
    LAS unsigned* PSUMU = (LAS unsigned*)(lds + L_PSUM);
    if (two) { for (int u = tid; u < 128 * 65; u += 512) PSUMU[u] = 0u; }
    __syncthreads();
    const LAS float* biasr = BIAS + r * 128; const float bfar = biasr[127];
    { const int nt = two ? 2 : 1;
      float mx = NEG, ls = 0.f;
#pragma unroll 1
      for (int tt = 0; tt < nt; ++tt) {
          f32x16 a0, a1;
          qk_tile(a0, a1, lds + L_K + tt * KBUF, qf, r32, hh);
          logits<16, true>(a0, a1, tq - 31 - tt * 1024, 0x7fffffff, true, biasr, bfar, hh);
          float mt = max32(a0, a1); mt = fmaxf(mt, __shfl_xor(mt, 32));
          const float mnew = fmaxf(mx, mt); float ps = 0.f;
#pragma unroll
          for (int i = 0; i < 16; ++i) ps += __builtin_amdgcn_exp2f(a0[i] - mnew) + __builtin_amdgcn_exp2f(a1[i] - mnew);
          ls = ls * __builtin_amdgcn_exp2f(mx - mnew) + ps; mx = mnew;
      }
      ls += __shfl_xor(ls, 32);
      const float inv = 1.0f / ls;
      f32x16 o[2];
#pragma unroll
      for (int i = 0; i < 16; ++i) { o[0][i] = 0.f; o[1][i] = 0.f; }
      const int qc = qh * 32 + r32;
#pragma unroll 1
      for (int tt = 0; tt < nt; ++tt) {
          f32x16 a0, a1;
          qk_tile(a0, a1, lds + L_K + tt * KBUF, qf, r32, hh);
          logits<16, true>(a0, a1, tq - 31 - tt * 1024, 0x7fffffff, true, biasr, bfar, hh);
#pragma unroll
          for (int i = 0; i < 16; ++i) { a0[i] = __builtin_amdgcn_exp2f(a0[i] - mx); a1[i] = __builtin_amdgcn_exp2f(a1[i] - mx); }
          if (two) {
              const float fx = inv * 268435456.0f;
              LAS unsigned* pb = PSUMU + (tt * 64 + 4 * hh) * 65 + qc;
#pragma unroll
              for (int i = 0; i < 16; ++i) { const int ci = (i & 3) + 8 * (i >> 2);
                  __hip_atomic_fetch_add(pb + ci * 65, (unsigned)(a0[i] * fx + 0.5f), __ATOMIC_RELAXED, __HIP_MEMORY_SCOPE_WORKGROUP);
                  __hip_atomic_fetch_add(pb + (ci + 32) * 65, (unsigned)(a1[i] * fx + 0.5f), __ATOMIC_RELAXED, __HIP_MEMORY_SCOPE_WORKGROUP); }
          }
          pv_tile(o, lds + L_V + tt * VBUF, a0, a1, lane);
      }
      const float sc = (tq >= 31) ? g_c * inv : 0.f;
#pragma unroll
      for (int i = 0; i < 16; ++i) { yacc[0][i] = sc * o[0][i]; yacc[1][i] = sc * o[1][i]; }
    }
    __syncthreads();
    if (two) {
#pragma unroll 1
        for (int ps = 0; ps < 4; ++ps) {
            const int q = ps * 16 + 2 * wid + hh, j = r32;
            const int dblk = qt - j;
            float v;
            if (j == 0 || (dblk >= 0 && dblk < 2)) v = 1.0e4f;
            else if (dblk < 0) v = -1.0e4f;
            else { const LAS unsigned* pc = PSUMU + (4 * j) * 65 + q; v = ((float)pc[-65] + 2.f * (float)pc[0] + 2.f * (float)pc[65] + 2.f * (float)pc[130] + (float)pc[195]) * (1.0f / 268435456.0f); }
            IMPV[q * 32 + j] = v;
        }
        __syncthreads();
#pragma unroll 1
        for (int ps = 0; ps < 4; ++ps) {
            const int q = ps * 16 + 2 * wid + hh, j = r32;
            const float v = IMPV[q * 32 + j]; int rank = 0;
#pragma unroll
            for (int jj = 0; jj < 32; ++jj) { const float o = IMPV[q * 32 + jj]; rank += (o > v || (o == v && jj < j)) ? 1 : 0; }
            const unsigned long long bal = __ballot(rank < 16);
            if (r32 == 0) SEL[q] = hh ? (unsigned)(bal >> 32) : (unsigned)bal;
        }
        __syncthreads();
    }
    const unsigned selmask = two ? SEL[qh * 32 + r32] : 0xffffffffu;
    __syncthreads();
    branch<1>(lds, T, b, g, qt, tq, qf, biasr, bfar, selmask, g_s, yacc, tid, lane);
    branch<2>(lds, T, b, g, qt, tq, qf, biasr, bfar, 0xffffffffu, g_w, yacc, tid, lane);
    { bf16* yp = T.y + (size_t)(b * SEQ + tq) * DM + LRUW + head * 64;
      float ss = 0.f;
#pragma unroll
      for (int db = 0; db < 2; ++db)
#pragma unroll
          for (int i4 = 0; i4 < 4; ++i4) {
              const float v0 = yacc[db][4 * i4], v1 = yacc[db][4 * i4 + 1], v2 = yacc[db][4 * i4 + 2], v3 = yacc[db][4 * i4 + 3];
              ss += (v0 * v0 + v1 * v1) + (v2 * v2 + v3 * v3);
              v2u w; w.x = cvtpk(v0, v1); w.y = cvtpk(v2, v3);
              *(v2u*)(yp + db * 32 + 8 * i4 + 4 * hh) = w;
          }
      ss += __shfl_xor(ss, 32);
      if (hh == 0) SSQ[r * 64 + qh * 32 + r32] = ss;
      __syncthreads();
      if (tid < 64) T.ssn[(size_t)(b * SEQ + t0 + tid) * 4 + g] = (SSQ[tid] + SSQ[64 + tid]) + (SSQ[128 + tid] + SSQ[192 + tid]);
      __syncthreads(); }
}
#undef NSA_MFMA
}
namespace lru {
constexpr int TC = 128;
constexpr int L_XF = 0, L_AF = 32768, L_XB = 65536, XBP = 144, L_SEG = L_XB + TC * XBP, L_CARRY = L_SEG + 4096, L_SQ = L_CARRY + 256, L_END = L_SQ + TC * 65 * 4;
static_assert(L_END <= RING_BYTES, "lru LDS");
typedef float f32x4_ __attribute__((ext_vector_type(4)));
struct Tens { const bf16* z; const float *conv_w, *conv_b, *wa, *ba, *wx, *bx, *lam; bf16* y; float* ssl; };

__device__ __forceinline__ void unit(LAS char* lds, const Tens& T, int b, int n) {
    const int tid = threadIdx.x, lane = tid & 63, w = __builtin_amdgcn_readfirstlane(tid >> 6);
    const int c = lane, ch = n * 64 + c;
    LAS float* XF = (LAS float*)(lds + L_XF); LAS float* AF = (LAS float*)(lds + L_AF);
    LAS float* SEGA = (LAS float*)(lds + L_SEG); LAS float* SEGH = SEGA + 512;
    LAS float* CARRY = (LAS float*)(lds + L_CARRY); LAS float* YSQ = (LAS float*)(lds + L_SQ);
    const float cw0 = T.conv_w[ch], cw1 = T.conv_w[1024 + ch], cw2 = T.conv_w[2048 + ch], cw3 = T.conv_w[3072 + ch], cb = T.conv_b[ch];
    bf16x8 fwa[4][2], fwx[4][2]; float bar[4], bxr[4], clc[4];
    { const int kq = lane >> 4, jc = lane & 15;
#pragma unroll
      for (int cb4 = 0; cb4 < 4; ++cb4) {
          const int col = 16 * cb4 + jc;
#pragma unroll
          for (int ks = 0; ks < 2; ++ks) {
              unsigned short ea[8], ex[8];
#pragma unroll
              for (int e = 0; e < 8; ++e) { const size_t o = (size_t)n * 4096 + (size_t)(8 * kq + e + 32 * ks) * 64 + col; ea[e] = (unsigned short)f2bf(T.wa[o]); ex[e] = (unsigned short)f2bf(T.wx[o]); }
              fwa[cb4][ks] = (bf16x8){(short)ea[0], (short)ea[1], (short)ea[2], (short)ea[3], (short)ea[4], (short)ea[5], (short)ea[6], (short)ea[7]};
              fwx[cb4][ks] = (bf16x8){(short)ex[0], (short)ex[1], (short)ex[2], (short)ex[3], (short)ex[4], (short)ex[5], (short)ex[6], (short)ex[7]};
          }
          bar[cb4] = T.ba[n * 64 + col]; bxr[cb4] = T.bx[n * 64 + col];
          const float lm = T.lam[n * 64 + col];
          clc[cb4] = -8.0f * log1pf(expf(-lm)) * LOG2E;
      } }
    if (tid < 64) CARRY[tid] = 0.f;
    const bf16* zu = T.z + (size_t)b * SEQ * ZP + C_U + ch;
    const bf16* zg = T.z + (size_t)b * SEQ * ZP + C_GL + ch;
#pragma unroll 1
    for (int chunk = 0; chunk < SEQ / TC; ++chunk) {
        const int tb = chunk * TC + 16 * w;
        unsigned short gl[16];
#pragma unroll
        for (int i = 0; i < 16; ++i) gl[i] = zg[(size_t)(tb + i) * ZP];
        float uu[19];
#pragma unroll
        for (int k = 0; k < 19; ++k) { const int t = tb - 3 + k; uu[k] = (t >= 0) ? bf2f(zu[(size_t)t * ZP]) : 0.f; }
#pragma unroll
        for (int i = 0; i < 16; ++i) {
            const float xc = cb + cw0 * uu[i] + cw1 * uu[i + 1] + cw2 * uu[i + 2] + cw3 * uu[i + 3];
            XF[(16 * w + i) * 64 + c] = xc;
            *(LAS unsigned short*)(lds + L_XB + (16 * w + i) * XBP + c * 2) = (unsigned short)f2bf(xc);
        }
        __syncthreads();
        { const int kq = lane >> 4, jc = lane & 15;
          const bf16x8 fa0 = *(const LAS bf16x8*)(lds + L_XB + (16 * w + jc) * XBP + (8 * kq) * 2), fa1 = *(const LAS bf16x8*)(lds + L_XB + (16 * w + jc) * XBP + (8 * kq + 32) * 2);
#pragma unroll
          for (int cb4 = 0; cb4 < 4; ++cb4) {
              f32x4_ ar = {0.f, 0.f, 0.f, 0.f}, ax = {0.f, 0.f, 0.f, 0.f};
              ar = __builtin_amdgcn_mfma_f32_16x16x32_bf16(fa0, fwa[cb4][0], ar, 0, 0, 0); ar = __builtin_amdgcn_mfma_f32_16x16x32_bf16(fa1, fwa[cb4][1], ar, 0, 0, 0);
              ax = __builtin_amdgcn_mfma_f32_16x16x32_bf16(fa0, fwx[cb4][0], ax, 0, 0, 0); ax = __builtin_amdgcn_mfma_f32_16x16x32_bf16(fa1, fwx[cb4][1], ax, 0, 0, 0);
              const int col = 16 * cb4 + jc;
#pragma unroll
              for (int e = 0; e < 4; ++e) {
                  const int tt = 16 * w + 4 * kq + e;
                  const float rg = sigmoidf_(ar[e] + bar[cb4]), ig = sigmoidf_(ax[e] + bxr[cb4]);
                  const float a = __builtin_amdgcn_exp2f(clc[cb4] * rg);
                  const float xcv = XF[tt * 64 + col];
                  AF[tt * 64 + col] = a;
                  XF[tt * 64 + col] = __builtin_amdgcn_sqrtf(fmaxf(1.0f - a * a, 0.f)) * (ig * xcv);
              }
          } }
        __syncthreads();
        float av[16], bv[16];
#pragma unroll
        for (int i = 0; i < 16; ++i) { av[i] = AF[(16 * w + i) * 64 + c]; bv[i] = XF[(16 * w + i) * 64 + c]; }
        { float A = 1.f, H = 0.f;
#pragma unroll
          for (int i = 0; i < 16; ++i) { H = av[i] * H + bv[i]; A *= av[i]; }
          SEGA[w * 64 + c] = A; SEGH[w * 64 + c] = H; }
        __syncthreads();
        float h = CARRY[c];
        for (int s = 0; s < w; ++s) h = SEGA[s * 64 + c] * h + SEGH[s * 64 + c];
        bf16* yp = T.y + (size_t)(b * SEQ + tb) * DM + ch;
#pragma unroll
        for (int i = 0; i < 16; ++i) {
            h = av[i] * h + bv[i];
            const float yv = h * pg8::gelu_tanh(bf2f(gl[i]));
            yp[(size_t)i * DM] = (bf16)f2bf(yv);
            YSQ[(16 * w + i) * 65 + c] = yv * yv;
        }
        __syncthreads();
        if (w == 7) CARRY[c] = h;
        if (tid < TC) { float s = 0.f;
#pragma unroll 8
            for (int k = 0; k < 64; ++k) s += YSQ[tid * 65 + k];
            T.ssl[(size_t)(b * SEQ + chunk * TC + tid) * 16 + n] = s; }
    }
    __syncthreads();
}
}
struct Frame {
    LAS unsigned char* lds; volatile LAS unsigned* MISC; gu32* ctl;
    int tid, lane, wave, vcu, G;
};
struct Args { const float* in[28]; float* out; unsigned char* ws; int ph_lo, ph_hi; };

__device__ __forceinline__ void p0_transpose_item(const float* W, int K, int N, int NP, bf16* WT, LAS float* scr, int item, int lane) {
    const int nblk = NP / 32, kb = item / nblk, nb = item % nblk, k0 = 64 * kb, n0 = 32 * nb;
    const int nn = n0 + (lane & 31);
#pragma unroll 8
    for (int i = 0; i < 32; ++i) { const int kk = 2 * i + (lane >> 5); scr[kk * 33 + (lane & 31)] = (nn < N) ? W[(size_t)(k0 + kk) * N + nn] : 0.f; }
    LDS_WAIT(); asm volatile("" ::: "memory");
    const int c = lane & 7;
#pragma unroll
    for (int j = 0; j < 4; ++j) { const int n = (lane >> 3) + 8 * j; const LAS float* s = scr + (8 * c) * 33 + n;
        v4u o; o.x = pk2(s[0 * 33], s[1 * 33]); o.y = pk2(s[2 * 33], s[3 * 33]); o.z = pk2(s[4 * 33], s[5 * 33]); o.w = pk2(s[6 * 33], s[7 * 33]);
        *(GAS v4u*)(WT + (size_t)(n0 + n) * K + k0 + 8 * c) = o; }
    LDS_WAIT(); asm volatile("" ::: "memory");
}
__device__ __forceinline__ void rms_row_to_bf16(const float* xrow, const float* g, bf16* orow, int lane) {
    f32x4 v[8]; float s = 0.f;
#pragma unroll
    for (int j = 0; j < 8; ++j) { v[j] = *(const f32x4*)(xrow + 4 * (lane + 64 * j)); s += (v[j].x * v[j].x + v[j].y * v[j].y) + (v[j].z * v[j].z + v[j].w * v[j].w); }
    const float rs = 1.0f / sqrtf(wave_sum(s) * (1.0f / DM) + NORM_EPS);
#pragma unroll
    for (int j = 0; j < 8; ++j) { const f32x4 gg = *(const f32x4*)(g + 4 * (lane + 64 * j)); v2u o; o.x = pk2(v[j].x * rs * gg.x, v[j].y * rs * gg.y); o.y = pk2(v[j].z * rs * gg.z, v[j].w * rs * gg.w);
        *(v2u*)(orow + 4 * (lane + 64 * j)) = o; }
}

__global__ void __launch_bounds__(NWAVES * 64, 2) hymba_fwd(Args args) {
    extern __shared__ __attribute__((aligned(16))) unsigned char lds[];
    Frame F;
    F.lds = (LAS unsigned char*)lds; F.MISC = (volatile LAS unsigned*)(F.lds + MISC_OFF);
    F.tid = threadIdx.x; F.lane = F.tid & 63; F.wave = __builtin_amdgcn_readfirstlane(F.tid >> 6);
    F.G = gridDim.x; { const int bx = blockIdx.x; F.vcu = (F.G % 8 == 0) ? (bx % 8) * (F.G / 8) + bx / 8 : bx; }
    unsigned char* ws = args.ws;
    F.ctl = (gu32*)(ws + WS_CTL);
    for (int u = F.tid; u < (LDS_BYTES - LDSCTL_OFF) / 4; u += NWAVES * 64) ((LAS unsigned*)(F.lds + LDSCTL_OFF))[u] = 0u;
    __syncthreads();
    XcdBarrier bar = xcd_barrier_post((unsigned*)(F.ctl + CW_BAR), F.MISC + 8);
    const int lo = args.ph_lo, hi = args.ph_hi;
#ifndef PHMASK
#define PHMASK 0xfff
#endif
#define IN(k) (((PHMASK >> (k)) & 1) && lo <= (k) && (k) < hi)
#define SEAM(k) do { if (IN(k) && IN((k) + 1)) xcd_barrier(bar); } while (0)
    const float* x = args.in[0]; const float* p_in = args.in[1];
    const float *g_mix_pre = args.in[2], *g_mix_post = args.in[3], *g_mlp_pre = args.in[4], *g_mlp_post = args.in[5];
    const float* w_in = args.in[6];
    const float *conv_w = args.in[7], *conv_b = args.in[8], *lru_wa = args.in[9], *lru_ba = args.in[10], *lru_wx = args.in[11], *lru_bx = args.in[12], *lru_lam = args.in[13];
    const float *pe_k = args.in[14], *cw1_k = args.in[15], *cw2_k = args.in[16], *pe_v = args.in[17], *cw1_v = args.in[18], *cw2_v = args.in[19];
    const float* rel_bias = args.in[20]; const float *gn_lru = args.in[21], *gn_nsa = args.in[22];
    const float *w_out = args.in[23], *mlp_w1 = args.in[24], *mlp_w2 = args.in[25], *ple_gate = args.in[26], *ple_proj = args.in[27];
    float* out = args.out;
    bf16 *Win_t = (bf16*)(ws + WS_WIN), *Wout_t = (bf16*)(ws + WS_WOUT), *W1_t = (bf16*)(ws + WS_W1), *W2_t = (bf16*)(ws + WS_W2), *Wg_t = (bf16*)(ws + WS_WG), *Wp_t = (bf16*)(ws + WS_WP);
    bf16 *Cw1k_t = (bf16*)(ws + WS_CW1K), *Cw1v_t = (bf16*)(ws + WS_CW1V);
    float* b1part = (float*)(ws + WS_MISC); float* bias1 = (float*)(ws + WS_MISC + 65536);
    bf16* PB = (bf16*)(ws + WS_PB); bf16* HID = (bf16*)(ws + WS_HID); bf16* KCVC = (bf16*)(ws + WS_KCVC);
    float *SSL = (float*)(ws + WS_SSL), *SSN = (float*)(ws + WS_SSN), *SSQ = (float*)(ws + WS_SSQ);
    bf16 *A = (bf16*)(ws + WS_A), *Z = (bf16*)(ws + WS_Z), *Y = (bf16*)(ws + WS_Y), *TT = (bf16*)(ws + WS_T), *HID2 = (bf16*)(ws + WS_HID2), *FF = (bf16*)(ws + WS_F), *PP = (bf16*)(ws + WS_PP);
    const int gw = F.vcu * NWAVES + F.wave, NGW = F.G * NWAVES;

    if (IN(0)) {
        LAS float* scr = (LAS float*)(F.lds + RING_OFF + F.wave * 16384);
        constexpr int I_IN = (DM / 64) * (ZP / 32), I_OUT = (DM / 64) * (DM / 32), I_1 = (DM / 64) * (DFF / 32), I_2 = (DFF / 64) * (DM / 32), I_G = I_OUT, I_P = (PLE / 64) * (DM / 32), I_C = (CMP_K / 64) * (CMP_H / 32);
        constexpr int NITEMS = I_IN + I_OUT + I_1 + I_2 + I_G + I_P + 2 * I_C;
        for (int it = gw; it < NITEMS; it += NGW) {
            int r = it;
            if (r < I_IN) { p0_transpose_item(w_in, DM, IN_DIM, ZP, Win_t, scr, r, F.lane); continue; } r -= I_IN;
            if (r < I_OUT) { p0_transpose_item(w_out, DM, DM, DM, Wout_t, scr, r, F.lane); continue; } r -= I_OUT;
            if (r < I_1) { p0_transpose_item(mlp_w1, DM, DFF, DFF, W1_t, scr, r, F.lane); continue; } r -= I_1;
            if (r < I_2) { p0_transpose_item(mlp_w2, DFF, DM, DM, W2_t, scr, r, F.lane); continue; } r -= I_2;
            if (r < I_G) { p0_transpose_item(ple_gate, DM, DM, DM, Wg_t, scr, r, F.lane); continue; } r -= I_G;
            if (r < I_P) { p0_transpose_item(ple_proj, PLE, DM, DM, Wp_t, scr, r, F.lane); continue; } r -= I_P;
            if (r < I_C) { p0_transpose_item(cw1_k, CMP_K, CMP_H, CMP_H, Cw1k_t, scr, r, F.lane); continue; } r -= I_C;
            p0_transpose_item(cw1_v, CMP_K, CMP_H, CMP_H, Cw1v_t, scr, r, F.lane);
        }
        for (int m = gw; m < MTOK; m += NGW) rms_row_to_bf16(x + (size_t)m * DM, g_mix_pre, A + (size_t)m * DM, F.lane);
        for (int m = gw; m < MTOK; m += NGW) { const f32x4 v = *(const f32x4*)(p_in + (size_t)m * PLE + 4 * F.lane); v2u o; o.x = pk2(v.x, v.y); o.y = pk2(v.z, v.w); *(v2u*)(PB + (size_t)m * PLE + 4 * F.lane) = o; }
        for (int it = gw; it < 256; it += NGW) {
            const int ten = it >> 7, ks = (it >> 3) & 15, cg = it & 7, col = cg * 32 + (F.lane & 31), kh = F.lane >> 5;
            const float* pe = ten ? pe_v : pe_k; const float* w1 = ten ? cw1_v : cw1_k; float s = 0.f;
            for (int k = 0; k < 64; ++k) { const int kk = ks * 128 + kh * 64 + k; s += pe[kk] * w1[(size_t)kk * CMP_H + col]; }
            s += __shfl_xor(s, 32);
            if (kh == 0) b1part[(ten * 16 + ks) * 256 + col] = s;
        }
    }
    SEAM(0);
    if (IN(1)) {
        if (blockIdx.x == 0) { const int ten = F.tid >> 8, col = F.tid & 255; float s = 0.f;
            for (int ks = 0; ks < 16; ++ks) s += b1part[(ten * 16 + ks) * 256 + col];
            bias1[ten * 256 + col] = s; }
        pg8::Gemm g{A, Win_t, MTOK, ZP, DM}; pg8::StaticOrder S; S.init(MTOK, ZP, F.G, (int)blockIdx.x);
        pg8::EpiAct<0> E{Z, ZP, nullptr};
        pg8::gemm_phase<pg8::EpiAct<0>, pg8::StaticOrder, pg8::AMapPlain, true, true>(F.lds + RING_OFF, g, S, E);
    }
    SEAM(1);
    if (IN(2)) {
        { lru::Tens T{Z, conv_w, conv_b, lru_wa, lru_ba, lru_wx, lru_bx, lru_lam, Y, SSL};
          for (int u = F.vcu; u < BATCH * 16; u += F.G) lru::unit((LAS char*)F.lds, T, u >> 4, u & 15); }
        { pg8::Gemm g{Z + C_KC, Cw1k_t, 8192, CMP_H, CMP_K}; pg8::StaticOrder S; S.init(8192, CMP_H, F.G, (int)blockIdx.x);
          pg8::EpiAct<2> E{HID, CMP_H, bias1};
          pg8::gemm_phase<pg8::EpiAct<2>, pg8::StaticOrder, pg8::AMapCmp, false, true>(F.lds + RING_OFF, g, S, E); }
        __syncthreads();
        { pg8::Gemm g{Z + C_VC, Cw1v_t, 8192, CMP_H, CMP_K}; pg8::StaticOrder S; S.init(8192, CMP_H, F.G, (int)((blockIdx.x + 128) % F.G));
          pg8::EpiAct<2> E{HID + (size_t)8192 * CMP_H, CMP_H, bias1 + 256};
          pg8::gemm_phase<pg8::EpiAct<2>, pg8::StaticOrder, pg8::AMapCmp, false, true>(F.lds + RING_OFF, g, S, E); }
    }
    SEAM(2);
    if (IN(3)) {
        for (int it = F.vcu * 512 + F.tid; it < 2 * 8192 * 8; it += F.G * 512) {
            const int row = it >> 3, c8 = it & 7, ten = row >> 13;
            const float* w2 = (ten ? cw2_v : cw2_k) + c8 * 8;
            float acc[8] = {0.f, 0.f, 0.f, 0.f, 0.f, 0.f, 0.f, 0.f};
            if ((row & 127) != 127) {
                const bf16* hp = HID + (size_t)row * CMP_H;
                for (int k8 = 0; k8 < 32; ++k8) {
                    const v4u hw = *(const v4u*)(hp + k8 * 8); const unsigned hu[4] = {hw.x, hw.y, hw.z, hw.w};
#pragma unroll
                    for (int e = 0; e < 8; ++e) { const float hv = (e & 1) ? bfhi(hu[e >> 1]) : bflo(hu[e >> 1]);
                        const f32x4 wa = *(const f32x4*)(w2 + (size_t)(k8 * 8 + e) * 64), wb = *(const f32x4*)(w2 + (size_t)(k8 * 8 + e) * 64 + 4);
                        acc[0] += hv * wa.x; acc[1] += hv * wa.y; acc[2] += hv * wa.z; acc[3] += hv * wa.w; acc[4] += hv * wb.x; acc[5] += hv * wb.y; acc[6] += hv * wb.z; acc[7] += hv * wb.w; }
                }
            }
            v4u o; o.x = pk2(acc[0], acc[1]); o.y = pk2(acc[2], acc[3]); o.z = pk2(acc[4], acc[5]); o.w = pk2(acc[6], acc[7]);
            *(v4u*)(KCVC + (size_t)row * 64 + c8 * 8) = o;
        }
    }
    SEAM(3);
    if (IN(4)) {
        nsa::Tens T{Z, KCVC, rel_bias, Y, SSN};
        for (int v = F.vcu; v < 256; v += F.G) {
            const int bg = v >> 2, k = v & 3;
#pragma unroll 1
            for (int i = 7; i >= 0; --i) { const int qt = 8 * (i >> 1) + ((i & 1) ? 7 - k : k); nsa::unit((LAS char*)F.lds, T, bg >> 2, bg & 3, qt); }
        }
    }
    SEAM(4);
    if (IN(5)) {
        for (int m = gw; m < MTOK; m += NGW) {
            float sl = (F.lane < 16) ? SSL[(size_t)m * 16 + F.lane] : 0.f, sn = (F.lane < 4) ? SSN[(size_t)m * 4 + F.lane] : 0.f;
            sl = wave_sum(sl); sn = wave_sum(sn);
            const float rl = 1.0f / sqrtf(sl * (1.0f / 1024.f) + NORM_EPS), rn = 1.0f / sqrtf(sn * (1.0f / 1024.f) + NORM_EPS);
            bf16* yr = Y + (size_t)m * DM;
#pragma unroll
            for (int j = 0; j < 4; ++j) { const int c0 = 8 * (F.lane + 64 * j); const float rs = (j < 2) ? rl : rn; const float* gp = (j < 2) ? (gn_lru + c0) : (gn_nsa + c0 - 1024);
                const v4u w = *(const v4u*)(yr + c0); const f32x4 g0 = *(const f32x4*)gp, g1 = *(const f32x4*)(gp + 4);
                v4u o; o.x = pk2(bflo(w.x) * rs * g0.x, bfhi(w.x) * rs * g0.y); o.y = pk2(bflo(w.y) * rs * g0.z, bfhi(w.y) * rs * g0.w);
                o.z = pk2(bflo(w.z) * rs * g1.x, bfhi(w.z) * rs * g1.y); o.w = pk2(bflo(w.w) * rs * g1.z, bfhi(w.w) * rs * g1.w);
                *(v4u*)(yr + c0) = o; }
        }
    }
    SEAM(5);
    if (IN(6)) {
        pg8::Gemm g{Y, Wout_t, MTOK, DM, DM}; pg8::StaticOrder S; S.init(MTOK, DM, F.G, (int)blockIdx.x);
        pg8::EpiSsq E{TT, DM, SSQ};
        pg8::gemm_phase<pg8::EpiSsq, pg8::StaticOrder, pg8::AMapPlain, true, true>(F.lds + RING_OFF, g, S, E);
    }
    SEAM(6);
    if (IN(7)) {
        for (int m = gw; m < MTOK; m += NGW) {
            float sq = (F.lane < 32) ? SSQ[(size_t)m * 32 + F.lane] : 0.f; sq = wave_sum(sq);
            const float rt = 1.0f / sqrtf(sq * (1.0f / DM) + NORM_EPS);
            const bf16* tr = TT + (size_t)m * DM; const float* xr = x + (size_t)m * DM; float* hr = out + (size_t)m * DM; bf16* ar = A + (size_t)m * DM;
            f32x4 h[4][2]; float s2 = 0.f;
#pragma unroll
            for (int j = 0; j < 4; ++j) { const int c0 = 8 * (F.lane + 64 * j);
                const v4u w = *(const v4u*)(tr + c0); const f32x4 x0 = *(const f32x4*)(xr + c0), x1 = *(const f32x4*)(xr + c0 + 4), g0 = *(const f32x4*)(g_mix_post + c0), g1 = *(const f32x4*)(g_mix_post + c0 + 4);
                h[j][0].x = x0.x + bflo(w.x) * rt * g0.x; h[j][0].y = x0.y + bfhi(w.x) * rt * g0.y; h[j][0].z = x0.z + bflo(w.y) * rt * g0.z; h[j][0].w = x0.w + bfhi(w.y) * rt * g0.w;
                h[j][1].x = x1.x + bflo(w.z) * rt * g1.x; h[j][1].y = x1.y + bfhi(w.z) * rt * g1.y; h[j][1].z = x1.z + bflo(w.w) * rt * g1.z; h[j][1].w = x1.w + bfhi(w.w) * rt * g1.w;
#pragma unroll
                for (int e = 0; e < 2; ++e) s2 += (h[j][e].x * h[j][e].x + h[j][e].y * h[j][e].y) + (h[j][e].z * h[j][e].z + h[j][e].w * h[j][e].w);
                *(f32x4*)(hr + c0) = h[j][0]; *(f32x4*)(hr + c0 + 4) = h[j][1]; }
            const float rh = 1.0f / sqrtf(wave_sum(s2) * (1.0f / DM) + NORM_EPS);
#pragma unroll
            for (int j = 0; j < 4; ++j) { const int c0 = 8 * (F.lane + 64 * j); const f32x4 g0 = *(const f32x4*)(g_mlp_pre + c0), g1 = *(const f32x4*)(g_mlp_pre + c0 + 4);
                v4u o; o.x = pk2(h[j][0].x * rh * g0.x, h[j][0].y * rh * g0.y); o.y = pk2(h[j][0].z * rh * g0.z, h[j][0].w * rh * g0.w);
                o.z = pk2(h[j][1].x * rh * g1.x, h[j][1].y * rh * g1.y); o.w = pk2(h[j][1].z * rh * g1.z, h[j][1].w * rh * g1.w);
                *(v4u*)(ar + c0) = o; }
        }
    }
    SEAM(7);
    if (IN(8)) {
        pg8::Gemm g{A, W1_t, MTOK, DFF, DM}; pg8::StaticOrder S; S.init(MTOK, DFF, F.G, (int)blockIdx.x);
        pg8::EpiAct<3> E{HID2, DFF, nullptr};
        pg8::gemm_phase<pg8::EpiAct<3>, pg8::StaticOrder, pg8::AMapPlain, true, true>(F.lds + RING_OFF, g, S, E);
    }
    SEAM(8);
    if (IN(9)) {
        pg8::Gemm g{HID2, W2_t, MTOK, DM, DFF}; pg8::StaticOrder S; S.init(MTOK, DM, F.G, (int)blockIdx.x);
        pg8::EpiSsq E{FF, DM, SSQ};
        pg8::gemm_phase<pg8::EpiSsq, pg8::StaticOrder, pg8::AMapPlain, true, true>(F.lds + RING_OFF, g, S, E);
    }
    SEAM(9);
    if (IN(10)) {
        for (int m = gw; m < MTOK; m += NGW) {
            float sq = (F.lane < 32) ? SSQ[(size_t)m * 32 + F.lane] : 0.f; sq = wave_sum(sq);
            const float rf = 1.0f / sqrtf(sq * (1.0f / DM) + NORM_EPS);
            const bf16* fr_ = FF + (size_t)m * DM; float* hr = out + (size_t)m * DM; bf16* ar = A + (size_t)m * DM;
#pragma unroll
            for (int j = 0; j < 4; ++j) { const int c0 = 8 * (F.lane + 64 * j);
                const v4u w = *(const v4u*)(fr_ + c0); f32x4 h0 = *(const f32x4*)(hr + c0), h1 = *(const f32x4*)(hr + c0 + 4); const f32x4 g0 = *(const f32x4*)(g_mlp_post + c0), g1 = *(const f32x4*)(g_mlp_post + c0 + 4);
                h0.x += bflo(w.x) * rf * g0.x; h0.y += bfhi(w.x) * rf * g0.y; h0.z += bflo(w.y) * rf * g0.z; h0.w += bfhi(w.y) * rf * g0.w;
                h1.x += bflo(w.z) * rf * g1.x; h1.y += bfhi(w.z) * rf * g1.y; h1.z += bflo(w.w) * rf * g1.z; h1.w += bfhi(w.w) * rf * g1.w;
                *(f32x4*)(hr + c0) = h0; *(f32x4*)(hr + c0 + 4) = h1;
                v4u o; o.x = pk2(h0.x, h0.y); o.y = pk2(h0.z, h0.w); o.z = pk2(h1.x, h1.y); o.w = pk2(h1.z, h1.w);
                *(v4u*)(ar + c0) = o; }
        }
        VM_WAIT(); __syncthreads();
        pg8::Gemm g{PB, Wp_t, MTOK, DM, PLE}; pg8::StaticOrder S; S.init(MTOK, DM, F.G, (int)blockIdx.x);
        pg8::EpiAct<0> E{PP, DM, nullptr};
        pg8::gemm_phase<pg8::EpiAct<0>, pg8::StaticOrder, pg8::AMapPlain, true, true>(F.lds + RING_OFF, g, S, E);
    }
    SEAM(10);
    if (IN(11)) {
        pg8::Gemm g{A, Wg_t, MTOK, DM, DM}; pg8::StaticOrder S; S.init(MTOK, DM, F.G, (int)blockIdx.x);
        pg8::EpiGate E{out, PP, DM};
        pg8::gemm_phase<pg8::EpiGate, pg8::StaticOrder, pg8::AMapPlain, true, true>(F.lds + RING_OFF, g, S, E);
    }
#undef IN
#undef SEAM
}

#ifndef MK_SPLIT
#define MK_SPLIT 0
#endif
extern "C" void kernel_launch(void* const* d_in, const int* in_sizes, int n_in, void* d_out, int out_size, void* d_ws, size_t ws_size, hipStream_t stream) {
    static int grid = 0;
    if (grid == 0) {
        if (n_in != 28 || out_size != MTOK * DM || ws_size < WS_END) { fprintf(stderr, "kernel_launch: unexpected shapes (n_in %d, out %d, ws %zu)\n", n_in, out_size, ws_size); grid = -1; return; }
        int dev = 0, cus = 0, per_cu = 0;
        if (hipGetDevice(&dev) != hipSuccess || hipDeviceGetAttribute(&cus, hipDeviceAttributeMultiprocessorCount, dev) != hipSuccess) { grid = -1; return; }
        if (hipFuncSetAttribute((const void*)hymba_fwd, hipFuncAttributeMaxDynamicSharedMemorySize, LDS_BYTES) != hipSuccess) { fprintf(stderr, "kernel_launch: hipFuncSetAttribute failed\n"); grid = -1; return; }
        if (hipOccupancyMaxActiveBlocksPerMultiprocessor(&per_cu, (const void*)hymba_fwd, NWAVES * 64, LDS_BYTES) != hipSuccess || per_cu < 1) { fprintf(stderr, "kernel_launch: occupancy query says %d\n", per_cu); (void)hipGetLastError(); }
        grid = cus;
    }
    if (grid < 0) return;
    (void)hipMemsetAsync((char*)d_ws + WS_CTL, 0, CTL_ZERO_BYTES, stream);
    Args a{};
    for (int i = 0; i < 28; ++i) a.in[i] = (const float*)d_in[i];
    a.out = (float*)d_out; a.ws = (unsigned char*)d_ws;
#if MK_SPLIT
    for (int ph = 0; ph < 12; ++ph) { a.ph_lo = ph; a.ph_hi = ph + 1; hipLaunchKernelGGL(hymba_fwd, dim3(grid), dim3(NWAVES * 64), LDS_BYTES, stream, a); }
#else
    a.ph_lo = 0; a.ph_hi = 12;
    hipLaunchKernelGGL(hymba_fwd, dim3(grid), dim3(NWAVES * 64), LDS_BYTES, stream, a);
#endif
}
```

```cpp
#include <hip/hip_runtime.h>
#include <cstdio>
#include <cstdint>

constexpr int BATCH = 16, SEQ = 2048, DM = 2048, MTOK = BATCH * SEQ;
constexpr int IN_DIM = 4656, ZP = 4864;
constexpr int C_U = 0, C_GL = 1024, C_Q = 2048, C_KC = 3072, C_VC = 3328, C_KS = 3584, C_VS = 3840, C_KW = 4096, C_VW = 4352, C_GT = 4608;
constexpr int DFF = 8192, PLE = 256, LRUW = 1024, NHEAD = 16, HD = 64, NKV = 4;
constexpr int NCMP = 127, NCMP_P = 128, CMP_K = 2048, CMP_H = 256;
constexpr float NORM_EPS = 1e-6f;
constexpr float LOG2E = 1.4426950408889634f;

namespace pg8 {
#define PG8_LAS __attribute__((address_space(3)))
typedef unsigned short bf16_t;
typedef short bf16x8 __attribute__((ext_vector_type(8)));
typedef float f32x4 __attribute__((ext_vector_type(4)));
typedef unsigned u32x4 __attribute__((ext_vector_type(4)));
constexpr int BM = 256, BK = 64, HALF = 128, HTB = HALF * BK * 2  , STAGE_BYTES = 8 * HTB, NXCD = 8, WGM = 8;

__host__ __device__ __forceinline__ int lds_byte(int r, int c) { const int st = (r >> 4) * 2 + (c >> 5), rr = r & 15, cc = c & 31, ob = rr * 64 + cc * 2; return st * 1024 + (ob ^ (((ob >> 9) & 1) << 5)); }
__host__ __device__ __forceinline__ void stage_rc(int b, int& R, int& C) { const int st = b / 1024, sb = b % 1024, swz = sb ^ (((sb >> 9) & 1) << 5); R = (st >> 1) * 16 + swz / 64; C = (st & 1) * 32 + (swz % 64) / 2; }
__host__ __device__ __forceinline__ int perm32(int rho) { const int n = rho >> 4, i = rho & 15; return 8 * (i >> 2) + 4 * n + (i & 3); }

struct Unit { int pm, pn; };
struct Gemm { const bf16_t* A; const bf16_t* Bt; int M, N, K; };

struct StaticOrder {
    int nM, nN, nwg, G, c;
    __host__ __device__ void init(int M, int N, int G_, int c_) { nM = M / BM; nN = N / BM; nwg = nM * nN; G = G_; c = c_; }
    __host__ __device__ bool next(int i, Unit& u) const {
        const long L = (long)i * G + c; if (L >= nwg) return false;
        int wgid = (int)L; { const int q = nwg / NXCD, r = nwg % NXCD, xcd = wgid % NXCD, off = wgid / NXCD; wgid = (xcd < r ? xcd * (q + 1) : r * (q + 1) + (xcd - r) * q) + off; }
        const int nig = WGM * nN, gid = wgid / nig, fm = gid * WGM, gsz = (nM - fm) < WGM ? (nM - fm) : WGM;
        u.pm = fm + ((wgid % nig) % gsz); u.pn = (wgid % nig) / gsz; return true;
    }
    __device__ __forceinline__ void a_ready(const Unit&) const {}
    __device__ __forceinline__ void done(const Unit&) const {}
};

__device__ __forceinline__ unsigned cvt_pk_bf16(float lo, float hi) { unsigned r; asm volatile("v_cvt_pk_bf16_f32 %0, %1, %2" : "=v"(r) : "v"(lo), "v"(hi)); return r; }
struct AMapPlain {
    __device__ static __forceinline__ int lda(const Gemm& g) { return g.K; }
    __device__ static __forceinline__ size_t kstep(const Gemm&) { return (size_t)(BK * 2); }
    __device__ static __forceinline__ size_t hstep(const Gemm& g) { return (size_t)HALF * g.K * 2; }
    __device__ static __forceinline__ const char* base(const Gemm& g, int pm) { return (const char*)g.A + (size_t)pm * 2 * HALF * g.K * 2; }
};
struct AMapCmp {
    __device__ static __forceinline__ int lda(const Gemm&) { return 16 * ZP; }
    __device__ static __forceinline__ size_t kstep(const Gemm&) { return (size_t)ZP * 2; }
    __device__ static __forceinline__ size_t hstep(const Gemm&) { return (size_t)128; }
    __device__ static __forceinline__ const char* base(const Gemm& g, int pm) { return (const char*)g.A + ((size_t)(pm >> 1) * SEQ * ZP + (size_t)(pm & 1) * 128) * 2; }
};

__device__ __forceinline__ float gelu_tanh(float v) {
    const float e = __builtin_amdgcn_exp2f(-2.302208198f * v * (1.0f + 0.044715f * v * v));
    return v * __builtin_amdgcn_rcpf(1.0f + e);
}
template <int ACT> struct EpiAct {
    static constexpr bool PERM = true, AFTER_DRAIN = false;
    bf16_t* O; int ldc; const float* bias; const float* rowscale;
    __device__ __forceinline__ void operator()(const f32x4 (&acc)[2][2][4][2], const Unit& u, int wr, int wc, int fr, int fq) const {
        const int row0 = u.pm * BM + wr * 64 + fr; const int col0 = u.pn * BM + wc * 32 + 8 * fq;
        f32x4 bv[2][2];
#pragma unroll
        for (int bj = 0; bj < 2; ++bj)
#pragma unroll
            for (int n = 0; n < 2; ++n) bv[bj][n] = bias ? *(const f32x4*)(bias + col0 + bj * HALF + 4 * n) : (f32x4){0.f, 0.f, 0.f, 0.f};
#pragma unroll
        for (int ai = 0; ai < 2; ++ai)
#pragma unroll
            for (int m = 0; m < 4; ++m) { bf16_t* rowp = O + (size_t)(row0 + ai * HALF + m * 16) * ldc + col0; const float rsc = rowscale ? rowscale[row0 + ai * HALF + m * 16] : 1.0f;
#pragma unroll
                for (int bj = 0; bj < 2; ++bj) { f32x4 v0 = acc[ai][bj][m][0] * rsc + bv[bj][0], v1 = acc[ai][bj][m][1] * rsc + bv[bj][1];
                    if (ACT == 2) {
#pragma unroll
                        for (int e = 0; e < 4; ++e) { v0[e] = gelu_tanh(v0[e]); v1[e] = gelu_tanh(v1[e]); } }
                    if (ACT == 3) {
#pragma unroll
                        for (int e = 0; e < 4; ++e) { const float a = fmaxf(v0[e], 0.f), b = fmaxf(v1[e], 0.f); v0[e] = a * a; v1[e] = b * b; } }
                    u32x4 w; w.x = cvt_pk_bf16(v0[0], v0[1]); w.y = cvt_pk_bf16(v0[2], v0[3]); w.z = cvt_pk_bf16(v1[0], v1[1]); w.w = cvt_pk_bf16(v1[2], v1[3]);
                    *(u32x4*)(rowp + bj * HALF) = w; } }
    }
};
struct EpiSsq {
    static constexpr bool PERM = true, AFTER_DRAIN = false;
    bf16_t* O; int ldc; float* ssq;
    __device__ __forceinline__ void operator()(const f32x4 (&acc)[2][2][4][2], const Unit& u, int wr, int wc, int fr, int fq) const {
        const int row0 = u.pm * BM + wr * 64 + fr; const int col0 = u.pn * BM + wc * 32 + 8 * fq;
#pragma unroll
        for (int ai = 0; ai < 2; ++ai)
#pragma unroll
            for (int m = 0; m < 4; ++m) { const int row = row0 + ai * HALF + m * 16; bf16_t* rowp = O + (size_t)row * ldc + col0; float s = 0.f;
#pragma unroll
                for (int bj = 0; bj < 2; ++bj) { const f32x4 v0 = acc[ai][bj][m][0], v1 = acc[ai][bj][m][1];
                    s += (v0[0] * v0[0] + v0[1] * v0[1]) + (v0[2] * v0[2] + v0[3] * v0[3]); s += (v1[0] * v1[0] + v1[1] * v1[1]) + (v1[2] * v1[2] + v1[3] * v1[3]);
                    u32x4 w; w.x = cvt_pk_bf16(v0[0], v0[1]); w.y = cvt_pk_bf16(v0[2], v0[3]); w.z = cvt_pk_bf16(v1[0], v1[1]); w.w = cvt_pk_bf16(v1[2], v1[3]);
                    *(u32x4*)(rowp + bj * HALF) = w; }
                s += __shfl_xor(s, 16); s += __shfl_xor(s, 32);
                if (fq == 0) ssq[(size_t)row * 32 + u.pn * 4 + wc] = s; }
    }
};
struct EpiGate {
    static constexpr bool PERM = true, AFTER_DRAIN = false;
    float* out; const bf16_t* h2; const bf16_t* pp; int ldc;
    __device__ __forceinline__ void operator()(const f32x4 (&acc)[2][2][4][2], const Unit& u, int wr, int wc, int fr, int fq) const {
        const int row0 = u.pm * BM + wr * 64 + fr; const int col0 = u.pn * BM + wc * 32 + 8 * fq;
#pragma unroll
        for (int ai = 0; ai < 2; ++ai)
#pragma unroll
            for (int m = 0; m < 4; ++m) { const size_t ro = (size_t)(row0 + ai * HALF + m * 16) * ldc + col0;
#pragma unroll
                for (int bj = 0; bj < 2; ++bj) { const f32x4 v0 = acc[ai][bj][m][0], v1 = acc[ai][bj][m][1];
                    const u32x4 pw = *(const u32x4*)(pp + ro + bj * HALF), hw = *(const u32x4*)(h2 + ro + bj * HALF); float* op = out + ro + bj * HALF;
                    const unsigned pu[4] = {pw.x, pw.y, pw.z, pw.w}, hu[4] = {hw.x, hw.y, hw.z, hw.w};
                    f32x4 h0, h1;
#pragma unroll
                    for (int e = 0; e < 4; ++e) { h0[e] = __uint_as_float((e & 1) ? (hu[e >> 1] & 0xffff0000u) : (hu[e >> 1] << 16)); h1[e] = __uint_as_float((e & 1) ? (hu[2 + (e >> 1)] & 0xffff0000u) : (hu[2 + (e >> 1)] << 16)); }
#pragma unroll
                    for (int e = 0; e < 4; ++e) { const float p0 = __uint_as_float((e & 1) ? (pu[e >> 1] & 0xffff0000u) : (pu[e >> 1] << 16));
                        const float p1 = __uint_as_float((e & 1) ? (pu[2 + (e >> 1)] & 0xffff0000u) : (pu[2 + (e >> 1)] << 16));
                        h0[e] += __builtin_amdgcn_rcpf(1.0f + __builtin_amdgcn_exp2f(-LOG2E * v0[e])) * p0;
                        h1[e] += __builtin_amdgcn_rcpf(1.0f + __builtin_amdgcn_exp2f(-LOG2E * v1[e])) * p1; }
                    *(f32x4*)op = h0; *(f32x4*)(op + 4) = h1; } }
    }
};
template <class Epi, class Sched, class AM, bool ALIGN_EPI = false, bool SP2 = false>
__device__ __forceinline__ void gemm_phase(PG8_LAS unsigned char* lds, const Gemm g, const Sched& S, const Epi& E) {
    const int tid = threadIdx.x, wid = __builtin_amdgcn_readfirstlane(tid >> 6), lane = tid & 63, wr = wid >> 2, wc = wid & 3, fr = lane & 15, fq = lane >> 4;
    const int K = g.K, nt = K / BK;
    unsigned voffA[2], voffB[2];
#pragma unroll
    for (int i = 0; i < 2; ++i) { int R, C; stage_rc(tid * 16 + i * 8192, R, C); const int Rb = Epi::PERM ? ((R & ~31) + perm32(R & 31)) : R;
        voffA[i] = (unsigned)(R * AM::lda(g) + C) * 2u; voffB[i] = (unsigned)(Rb * K + C) * 2u; }
    const size_t kstep = (size_t)(BK * 2); const size_t kstepA = AM::kstep(g), hstepA = AM::hstep(g);
    const size_t hstep = (size_t)HALF * K * 2;
    const size_t tstep = 2 * hstep;
    const unsigned ldsw = (unsigned)wid * 1024u;
    const int aoff = lds_byte(wr * 64 + fr, fq * 8), boff = lds_byte(wc * 32 + fr, fq * 8);
#define PG8_SA(b, h) (((b) * 2 + (h)) * HTB)
#define PG8_SB(b, h) ((4 + (b) * 2 + (h)) * HTB)
#define PG8_STAGE(bufoff, gbase, voff) do { _Pragma("unroll") for (int _i = 0; _i < 2; ++_i) \
        __builtin_amdgcn_global_load_lds((const unsigned*)((const char*)(gbase) + (voff)[_i]), (PG8_LAS unsigned*)(lds + (bufoff) + ldsw + _i * 8192), 16, 0, 0); } while (0)
#define PG8_LDA(dst, b, h) do { _Pragma("unroll") for (int m = 0; m < 4; ++m) _Pragma("unroll") for (int k = 0; k < 2; ++k) dst[m][k] = *(const PG8_LAS bf16x8*)(lds + PG8_SA(b, h) + aoff + m * 2048 + k * 1024); } while (0)
#define PG8_LDB(dst, b, h) do { _Pragma("unroll") for (int n = 0; n < 2; ++n) _Pragma("unroll") for (int k = 0; k < 2; ++k) dst[n][k] = *(const PG8_LAS bf16x8*)(lds + PG8_SB(b, h) + boff + n * 2048 + k * 1024); } while (0)
#define PG8_MMA(ai, bj, At, Bt) do { __builtin_amdgcn_s_setprio(1); _Pragma("unroll") for (int m = 0; m < 4; ++m) _Pragma("unroll") for (int n = 0; n < 2; ++n) _Pragma("unroll") for (int k = 0; k < 2; ++k) \
        acc[ai][bj][m][n] = __builtin_amdgcn_mfma_f32_16x16x32_bf16(Bt[n][k], At[m][k], acc[ai][bj][m][n], 0, 0, 0); __builtin_amdgcn_s_setprio(0); } while (0)
#define PG8_WAIT_V(n) asm volatile("s_waitcnt vmcnt(" #n ")" ::: "memory")
#define PG8_WAIT_L(n) asm volatile("s_waitcnt lgkmcnt(" #n ")" ::: "memory")
#define PG8_BAR __builtin_amdgcn_s_barrier()
#define PG8_SCHED __builtin_amdgcn_sched_barrier(0)
    Unit cur, nxt; int ui = 0;
    if (!S.next(0, cur)) return;
    f32x4 acc[2][2][4][2];
#pragma unroll
    for (int a = 0; a < 2; ++a)
#pragma unroll
        for (int b = 0; b < 2; ++b)
#pragma unroll
            for (int m = 0; m < 4; ++m)
#pragma unroll
                for (int n = 0; n < 2; ++n) acc[a][b][m][n] = (f32x4){0.f, 0.f, 0.f, 0.f};
    bf16x8 At[4][2], B0[2][2], B1[2][2];
    const char* cA = AM::base(g, cur.pm); const char* cB = (const char*)g.Bt + (size_t)cur.pn * tstep;
    S.a_ready(cur);
    if constexpr (SP2) {
        PG8_STAGE(PG8_SB(0, 0), cB, voffB); PG8_STAGE(PG8_SB(0, 1), cB + hstep, voffB); PG8_STAGE(PG8_SA(0, 0), cA, voffA); PG8_STAGE(PG8_SA(0, 1), cA + hstepA, voffA);
        if (wr == 1) PG8_BAR;
        PG8_WAIT_V(2); PG8_BAR;
        PG8_STAGE(PG8_SB(1, 0), cB + kstep, voffB); PG8_STAGE(PG8_SA(1, 0), cA + kstepA, voffA); PG8_STAGE(PG8_SB(1, 1), cB + hstep + kstep, voffB);
        PG8_WAIT_V(6); PG8_BAR;
    } else {
        PG8_STAGE(PG8_SB(0, 0), cB, voffB); PG8_STAGE(PG8_SA(0, 0), cA, voffA); PG8_STAGE(PG8_SB(0, 1), cB + hstep, voffB); PG8_STAGE(PG8_SA(0, 1), cA + hstepA, voffA);
        if (wr == 1) PG8_BAR;
        PG8_WAIT_V(4); PG8_BAR;
        PG8_STAGE(PG8_SB(1, 0), cB + kstep, voffB); PG8_STAGE(PG8_SA(1, 0), cA + kstepA, voffA); PG8_STAGE(PG8_SB(1, 1), cB + hstep + kstep, voffB);
        PG8_WAIT_V(6); PG8_BAR;
    }
    for (;;) {
        const bool has_next = S.next(ui + 1, nxt);
        const char* nA = has_next ? AM::base(g, nxt.pm) : cA; const char* nB = has_next ? (const char*)g.Bt + (size_t)nxt.pn * tstep : cB;
        for (int t = 0; t < nt; t += 2) {
            const bool last = (t == nt - 2);
            const char* a1 = cA + (size_t)(t + 1) * kstepA;
            const char* a2 = last ? nA : cA + (size_t)(t + 2) * kstepA; const char* b2 = last ? nB : cB + (size_t)(t + 2) * kstep;
            const char* a3 = a2 + kstepA; const char* b3 = b2 + kstep;
            if (last && has_next) S.a_ready(nxt);
            if constexpr (SP2) {
            PG8_LDB(B0, 0, 0); PG8_LDB(B1, 0, 1); PG8_SCHED; PG8_LDA(At, 0, 0); PG8_STAGE(PG8_SA(1, 1), a1 + hstepA, voffA);
            PG8_WAIT_V(8); PG8_WAIT_L(0); PG8_BAR; PG8_MMA(0, 0, At, B0); PG8_MMA(0, 1, At, B1); PG8_BAR; PG8_SCHED;
            PG8_LDA(At, 0, 1); PG8_STAGE(PG8_SB(0, 0), b2, voffB); PG8_STAGE(PG8_SB(0, 1), b2 + hstep, voffB); PG8_STAGE(PG8_SA(0, 0), a2, voffA);
            PG8_WAIT_V(8); PG8_WAIT_L(0); PG8_BAR; PG8_MMA(1, 0, At, B0); PG8_MMA(1, 1, At, B1); PG8_BAR; PG8_SCHED;
            PG8_LDB(B0, 1, 0); PG8_LDB(B1, 1, 1); PG8_SCHED; PG8_LDA(At, 1, 0); PG8_STAGE(PG8_SA(0, 1), a2 + hstepA, voffA);
            PG8_WAIT_V(8); PG8_WAIT_L(0); PG8_BAR; PG8_MMA(0, 0, At, B0); PG8_MMA(0, 1, At, B1); PG8_BAR; PG8_SCHED;
            PG8_LDA(At, 1, 1); PG8_STAGE(PG8_SB(1, 0), b3, voffB); PG8_STAGE(PG8_SB(1, 1), b3 + hstep, voffB); PG8_STAGE(PG8_SA(1, 0), a3, voffA);
            PG8_WAIT_V(8); PG8_WAIT_L(0); PG8_BAR; PG8_MMA(1, 0, At, B0); PG8_MMA(1, 1, At, B1); PG8_BAR; PG8_SCHED;
            } else {
            PG8_LDB(B0, 0, 0); PG8_SCHED; PG8_LDA(At, 0, 0); PG8_STAGE(PG8_SA(1, 1), a1 + hstepA, voffA);
            PG8_WAIT_L(8); PG8_BAR; PG8_WAIT_L(0); PG8_MMA(0, 0, At, B0); PG8_BAR; PG8_SCHED;
            PG8_LDB(B1, 0, 1); PG8_STAGE(PG8_SB(0, 0), b2, voffB);
            PG8_BAR; PG8_WAIT_L(0); PG8_MMA(0, 1, At, B1); PG8_BAR;
            PG8_LDA(At, 0, 1); PG8_STAGE(PG8_SA(0, 0), a2, voffA);
            PG8_BAR; PG8_WAIT_L(0); PG8_MMA(1, 0, At, B0); PG8_BAR; PG8_SCHED;
            PG8_STAGE(PG8_SB(0, 1), b2 + hstep, voffB);
            PG8_WAIT_V(6); PG8_BAR; PG8_MMA(1, 1, At, B1); PG8_BAR;
            PG8_LDB(B0, 1, 0); PG8_SCHED; PG8_LDA(At, 1, 0); PG8_STAGE(PG8_SA(0, 1), a2 + hstepA, voffA);
            PG8_WAIT_L(8); PG8_BAR; PG8_WAIT_L(0); PG8_MMA(0, 0, At, B0); PG8_BAR; PG8_SCHED;
            PG8_LDB(B1, 1, 1); PG8_STAGE(PG8_SB(1, 0), b3, voffB);
            PG8_BAR; PG8_WAIT_L(0); PG8_MMA(0, 1, At, B1); PG8_BAR;
            PG8_LDA(At, 1, 1); PG8_STAGE(PG8_SA(1, 0), a3, voffA);
            PG8_BAR; PG8_WAIT_L(0); PG8_MMA(1, 0, At, B0); PG8_BAR; PG8_SCHED;
            PG8_STAGE(PG8_SB(1, 1), b3 + hstep, voffB);
            PG8_WAIT_V(6); PG8_BAR; PG8_MMA(1, 1, At, B1); PG8_BAR;
            }
        }
        if constexpr (ALIGN_EPI) { if (wr == 0) PG8_BAR; }
        if constexpr (!Epi::AFTER_DRAIN) { E(acc, cur, wr, wc, fr, fq); S.done(cur); }
        if (!has_next) break;
#pragma unroll
        for (int a = 0; a < 2; ++a)
#pragma unroll
            for (int b = 0; b < 2; ++b)
#pragma unroll
                for (int m = 0; m < 4; ++m)
#pragma unroll
                    for (int n = 0; n < 2; ++n) acc[a][b][m][n] = (f32x4){0.f, 0.f, 0.f, 0.f};
        cur = nxt; cA = nA; cB = nB; ++ui;
        if constexpr (ALIGN_EPI) { if (wr == 1) PG8_BAR; }
    }
    PG8_WAIT_V(0);
    if constexpr (!ALIGN_EPI) { if (wr == 0) PG8_BAR; }
    PG8_BAR;
    if constexpr (Epi::AFTER_DRAIN) { E.fused(acc, cur, wr, wc, fr, fq, lds, wid, lane); S.done(cur); }
#undef PG8_SA
#undef PG8_SB
#undef PG8_STAGE
#undef PG8_LDA
#undef PG8_LDB
#undef PG8_MMA
#undef PG8_WAIT_V
#undef PG8_WAIT_L
#undef PG8_BAR
#undef PG8_SCHED
}
}
constexpr size_t MiB = 1u << 20;
constexpr size_t WS_CTL = 0, CTL_ZERO_BYTES = 1 * MiB;
constexpr size_t WS_WIN = 2 * MiB, WS_WOUT = 21 * MiB, WS_W1 = 29 * MiB, WS_W2 = 61 * MiB, WS_WG = 93 * MiB, WS_WP = 101 * MiB, WS_CW1K = 102 * MiB, WS_CW1V = 103 * MiB;
constexpr size_t WS_MISC = 104 * MiB;
constexpr size_t WS_PB = 105 * MiB;
constexpr size_t WS_HID = 121 * MiB;
constexpr size_t WS_KCVC = 129 * MiB;
constexpr size_t WS_SSL = 131 * MiB, WS_SSN = 133 * MiB;
constexpr size_t WS_SSQ = 134 * MiB;
constexpr size_t WS_A = 140 * MiB;
constexpr size_t WS_Z = 268 * MiB;
constexpr size_t WS_Y = 573 * MiB;
constexpr size_t WS_T = 701 * MiB;
constexpr size_t WS_HID2 = 268 * MiB;
constexpr size_t WS_F = 780 * MiB;
constexpr size_t WS_PP = 268 * MiB;
constexpr size_t WS_END = 908 * MiB;
constexpr int CW_TMO = 0, CW_CODE = 1, CW_BAR = 4096;

constexpr int RING_OFF = 0, RING_BYTES = 131072;
constexpr int LDSCTL_OFF = RING_BYTES, MISC_OFF = LDSCTL_OFF + 320;
constexpr int LDS_BYTES = 147456;
constexpr int NWAVES = 8;

#define GAS __attribute__((address_space(1)))
#define LAS __attribute__((address_space(3)))
typedef unsigned short bf16;
typedef unsigned v4u __attribute__((ext_vector_type(4)));
typedef unsigned v2u __attribute__((ext_vector_type(2)));
typedef float f32x4 __attribute__((ext_vector_type(4)));
typedef float f32x16 __attribute__((ext_vector_type(16)));
typedef short bf16x8 __attribute__((ext_vector_type(8)));
typedef short s16x4 __attribute__((ext_vector_type(4)));
typedef GAS unsigned gu32;
#define RLX_AGENT __ATOMIC_RELAXED, __HIP_MEMORY_SCOPE_AGENT
#define LDS_WAIT() asm volatile("s_waitcnt lgkmcnt(0)" ::: "memory")
#define VM_WAIT() asm volatile("s_waitcnt vmcnt(0)" ::: "memory")
__device__ __forceinline__ unsigned f2bf(float f) { unsigned u = __builtin_bit_cast(unsigned, f); return (u + 0x7fffu + ((u >> 16) & 1u)) >> 16; }
__device__ __forceinline__ unsigned pk2(float lo, float hi) { return f2bf(lo) | (f2bf(hi) << 16); }
__device__ __forceinline__ float bf2f(unsigned b) { return __uint_as_float(b << 16); }
__device__ __forceinline__ float bflo(unsigned w) { return __uint_as_float(w << 16); }
__device__ __forceinline__ float bfhi(unsigned w) { return __uint_as_float(w & 0xffff0000u); }
__device__ __forceinline__ float wave_sum(float v) {
#pragma unroll
    for (int o = 1; o < 64; o <<= 1) v += __shfl_xor(v, o);
    return v;
}
__device__ __forceinline__ float sigmoidf_(float v) { return __builtin_amdgcn_rcpf(1.0f + __builtin_amdgcn_exp2f(-LOG2E * v)); }
#define XB_TMO      128
#define XB_XCNT(j)  (256  + 64 * (j))
#define XB_XSUB(j)  (1280 + 64 * (j))
#define XB_XGEN(j)  (2304 + 64 * (j))
#define XB_TOP      3328
#define XB_TOPGEN   3392
#define XCD_BAR_WORDS 3456
#define XB_SPIN_CAP (1u << 18)

__device__ __forceinline__ unsigned xb_ld(unsigned* p)              { return __hip_atomic_load(p, __ATOMIC_RELAXED, __HIP_MEMORY_SCOPE_AGENT); }
__device__ __forceinline__ unsigned xb_add(unsigned* p, unsigned v) { return __hip_atomic_fetch_add(p, v, __ATOMIC_RELAXED, __HIP_MEMORY_SCOPE_AGENT); }
__device__ __forceinline__ unsigned xb_xcc_id() { return (unsigned)__builtin_amdgcn_s_getreg((3 << 11) | 20) & 0xFu; }
#define XB_SPIN(cond, bar) do { unsigned _sp = 0; while (cond) { __builtin_amdgcn_s_sleep(1); \
    if ((++_sp & 255u) == 0u) { if (xb_ld(&(bar)[XB_TMO])) break; if (_sp > XB_SPIN_CAP) { atomicAdd(&(bar)[XB_TMO], 1u); break; } } } } while (0)

struct XcdBarrier {
    unsigned* bar; unsigned x;
    volatile LAS unsigned* st;
};

__device__ __forceinline__ XcdBarrier xcd_barrier_post(unsigned* bar, volatile LAS unsigned* st) {
    XcdBarrier b; b.bar = bar; b.x = xb_xcc_id(); b.st = st;
    if (threadIdx.x == 0) (void)xb_add(&bar[XB_XCNT(b.x)], 1u);
    return b;
}
__device__ __forceinline__ void xcd_barrier_complete(unsigned* bar, unsigned x, unsigned& nloc, unsigned& nx) {
    const unsigned G = gridDim.x * gridDim.y * gridDim.z;
    unsigned sum, cnt, mine, sp = 0u;
    for (;;) {
        sum = 0u; cnt = 0u; mine = 0u;
#pragma unroll
        for (unsigned j = 0; j < 16; ++j) { const unsigned c = xb_ld(&bar[XB_XCNT(j)]); sum += c; cnt += (c > 0u) ? 1u : 0u; mine = (j == x) ? c : mine; }
        if (sum == G) break;
        __builtin_amdgcn_s_sleep(1);
        if ((++sp & 255u) == 0u) { if (xb_ld(&bar[XB_TMO])) break; if (sp > XB_SPIN_CAP) { atomicAdd(&bar[XB_TMO], 1u); break; } }
    }
    nloc = mine > 0u ? mine : 1u; nx = cnt > 0u ? cnt : 1u;
}

__device__ __forceinline__ void xcd_barrier(const XcdBarrier& b) {
    asm volatile("s_waitcnt vmcnt(0)" ::: "memory");
    __syncthreads();
    if (threadIdx.x == 0) {
        unsigned* bar = b.bar;
        __builtin_amdgcn_s_waitcnt(0);
        unsigned nloc = b.st[0], nx = b.st[1];
        if (nloc == 0u) { xcd_barrier_complete(bar, b.x, nloc, nx); b.st[0] = nloc; b.st[1] = nx; }
        const unsigned old = xb_add(&bar[XB_XSUB(b.x)], 1u);
        const unsigned gen = old / nloc;
        if (old + 1u == (gen + 1u) * nloc) {
            __builtin_amdgcn_fence(__ATOMIC_RELEASE, "agent");
            asm volatile("s_waitcnt vmcnt(0)" ::: "memory");
            const unsigned og = xb_add(&bar[XB_TOP], 1u);
            const unsigned tg = og / nx;
            if (og + 1u == (tg + 1u) * nx) xb_add(&bar[XB_TOPGEN], 1u);
            else XB_SPIN(xb_ld(&bar[XB_TOPGEN]) == tg, bar);
            __builtin_amdgcn_fence(__ATOMIC_ACQUIRE, "agent");
            xb_add(&bar[XB_XGEN(b.x)], 1u);
            asm volatile("s_waitcnt vmcnt(0)" ::: "memory");
        } else {
            XB_SPIN(xb_ld(&bar[XB_XGEN(b.x)]) == gen, bar);
            __builtin_amdgcn_fence(__ATOMIC_ACQUIRE, "agent");
            asm volatile("s_waitcnt vmcnt(0)" ::: "memory");
        }
    }
    __syncthreads();
}

namespace nsa {
constexpr int KPB = 144, VPB = 192;
constexpr int KBUF = 64 * KPB, VBUF = 64 * VPB;
constexpr int L_K = 0, L_V = 2 * KBUF, L_BIAS = L_V + 2 * VBUF, L_PSUM = L_BIAS + 2048, L_IMPV = L_PSUM + 128 * 65 * 4, L_SEL = L_IMPV + 64 * 32 * 4, L_STASH = L_PSUM  , L_SSQ = L_STASH + 65536, L_END = L_SSQ + 1024;
static_assert(L_SEL + 256 <= L_SSQ, "nsa LDS overlay");
static_assert(L_END <= RING_BYTES, "nsa LDS");
constexpr float NEG = -1.0e30f;
constexpr float C1 = 0.125f * LOG2E;
__device__ __forceinline__ int crow(int i, int hh) { return (i & 3) + 8 * (i >> 2) + 4 * hh; }
__device__ __forceinline__ int t5_bucket(int n) {
    if (n < 16) return n;
    int b = 16;
    b += (n >= 19); b += (n >= 21); b += (n >= 24); b += (n >= 27); b += (n >= 31); b += (n >= 35); b += (n >= 40); b += (n >= 46);
    b += (n >= 52); b += (n >= 59); b += (n >= 67); b += (n >= 77); b += (n >= 87); b += (n >= 99); b += (n >= 113);
    return b;
}
__device__ __forceinline__ s16x4 trr(const LAS char* p) { return __builtin_bit_cast(s16x4, __builtin_amdgcn_ds_read_tr16_b64_v4i16((LAS s16x4*)p)); }
__device__ __forceinline__ unsigned cvtpk(float lo, float hi) { typedef float f2 __attribute__((ext_vector_type(2))); typedef __bf16 b2 __attribute__((ext_vector_type(2))); f2 v = {lo, hi}; b2 r = __builtin_convertvector(v, b2); return __builtin_bit_cast(unsigned, r); }
#define NSA_MFMA(a, b, c) __builtin_amdgcn_mfma_f32_32x32x16_bf16((a), (b), (c), 0, 0, 0)

__device__ __forceinline__ void qk_tile(f32x16& s0, f32x16& s1, const LAS char* kbuf, const bf16x8 (&qf)[4], const f32x16& cin, int r32, int hh) {
    const LAS char* kb = kbuf + r32 * KPB + hh * 16;
    { const bf16x8 a0 = *(const LAS bf16x8*)(kb), a1 = *(const LAS bf16x8*)(kb + 32 * KPB);
      s0 = NSA_MFMA(a0, qf[0], cin); s1 = NSA_MFMA(a1, qf[0], cin); }
#pragma unroll
    for (int d0 = 1; d0 < 4; ++d0) {
        const bf16x8 a0 = *(const LAS bf16x8*)(kb + d0 * 32), a1 = *(const LAS bf16x8*)(kb + 32 * KPB + d0 * 32);
        s0 = NSA_MFMA(a0, qf[d0], s0); s1 = NSA_MFMA(a1, qf[d0], s1);
    }
}
__device__ __forceinline__ void pv_tile(f32x16 (&o)[2], f32x16& lacc, const LAS char* vbuf, const f32x16& p0, const f32x16& p1, int lane) {
    const int hh = lane >> 5, q4 = (lane & 15) >> 2, pp = lane & 3, blk = (lane >> 4) & 1;
    const LAS char* vb = vbuf + (4 * hh + q4) * VPB + blk * 32 + pp * 8;
    bf16x8 pf[4];
    { v4u w;
      w.x = cvtpk(p0[0], p0[1]); w.y = cvtpk(p0[2], p0[3]); w.z = cvtpk(p0[4], p0[5]); w.w = cvtpk(p0[6], p0[7]); pf[0] = __builtin_bit_cast(bf16x8, w);
      w.x = cvtpk(p0[8], p0[9]); w.y = cvtpk(p0[10], p0[11]); w.z = cvtpk(p0[12], p0[13]); w.w = cvtpk(p0[14], p0[15]); pf[1] = __builtin_bit_cast(bf16x8, w);
      w.x = cvtpk(p1[0], p1[1]); w.y = cvtpk(p1[2], p1[3]); w.z = cvtpk(p1[4], p1[5]); w.w = cvtpk(p1[6], p1[7]); pf[2] = __builtin_bit_cast(bf16x8, w);
      w.x = cvtpk(p1[8], p1[9]); w.y = cvtpk(p1[10], p1[11]); w.z = cvtpk(p1[12], p1[13]); w.w = cvtpk(p1[14], p1[15]); pf[3] = __builtin_bit_cast(bf16x8, w); }
    const bf16x8 ones = {0x3F80, 0x3F80, 0x3F80, 0x3F80, 0x3F80, 0x3F80, 0x3F80, 0x3F80};
#pragma unroll
    for (int s = 0; s < 4; ++s) lacc = NSA_MFMA(ones, pf[s], lacc);
#pragma unroll
    for (int db = 0; db < 2; ++db)
#pragma unroll
        for (int s = 0; s < 4; ++s) {
            const s16x4 lo = trr(vb + (16 * s) * VPB + db * 64), hi = trr(vb + (16 * s + 8) * VPB + db * 64);
            const bf16x8 vf = {lo[0], lo[1], lo[2], lo[3], hi[0], hi[1], hi[2], hi[3]};
            o[db] = NSA_MFMA(vf, pf[s], o[db]);
        }
}
template <int KS> __device__ __forceinline__ void gen_fix(f32x16& s0, f32x16& s1, int dq, int hi_excl, bool rowok, const LAS float* biasr, int hh) {
    const int dbase = dq - 4 * hh * KS;
#pragma unroll
    for (int i = 0; i < 16; ++i) {
        const int d0 = dbase - ((i & 3) + 8 * (i >> 2)) * KS, d1 = d0 - 32 * KS;
        const float b0 = biasr[min(max(d0, 0), 127)], b1 = biasr[min(max(d1, 0), 127)];
        const bool v0 = rowok && d0 >= 0 && d0 < hi_excl, v1 = rowok && d1 >= 0 && d1 < hi_excl;
        s0[i] = v0 ? s0[i] + b0 : NEG; s1[i] = v1 ? s1[i] + b1 : NEG;
    }
}
__device__ __forceinline__ float max32(const f32x16& a, const f32x16& b) {
    float m = fmaxf(a[0], b[0]);
#pragma unroll
    for (int i = 1; i < 16; ++i) m = fmaxf(m, fmaxf(a[i], b[i]));
    return m;
}
template <int KS, bool GEN> __device__ __forceinline__ void tile_step(const LAS char* kbuf, const LAS char* vbuf, const bf16x8 (&qf)[4], float& negm, f32x16 (&o)[2], f32x16& lacc,
                                                                       bool first, bool rowok, float bfar, int dq, int hi_excl, const LAS float* biasr, int lane) {
    const int r32 = lane & 31, hh = lane >> 5;
    constexpr float THR = 8.0f;
    const float cv = GEN ? negm : (rowok ? bfar + negm : NEG);
    f32x16 cin;
#pragma unroll
    for (int i = 0; i < 16; ++i) cin[i] = cv;
    f32x16 s0, s1;
    qk_tile(s0, s1, kbuf, qf, cin, r32, hh);
    if (GEN) gen_fix<KS>(s0, s1, dq, hi_excl, rowok, biasr, hh);
    float rm = max32(s0, s1); rm = fmaxf(rm, __shfl_xor(rm, 32));
    const bool need = first ? (rm > -1.0e29f) : (rm > THR);
    if (__any(need)) {
        const float dl = need ? rm : 0.f, alpha = __builtin_amdgcn_exp2f(-dl);
        negm -= dl;
#pragma unroll
        for (int i = 0; i < 16; ++i) { s0[i] -= dl; s1[i] -= dl; o[0][i] *= alpha; o[1][i] *= alpha; }
        lacc[0] *= alpha;
    }
#pragma unroll
    for (int i = 0; i < 16; ++i) { s0[i] = __builtin_amdgcn_exp2f(s0[i]); s1[i] = __builtin_amdgcn_exp2f(s1[i]); }
    pv_tile(o, lacc, vbuf, s0, s1, lane);
}

struct Tens { const bf16* z; const bf16* kcvc; const float* relb; bf16* y; float* ssn; };

__device__ __forceinline__ void branches(LAS char* lds, const Tens& T, int b, int g, int qt, int tq, const bf16x8 (&qf)[4], const LAS float* biasr, float bfar,
                                         unsigned selmask, float g_s, float g_w, LAS char* stash, int tid, int lane) {
    const int skey = tid >> 3, sch = tid & 7;
    const bf16* rowp = T.z + (size_t)(b * SEQ + skey) * ZP + g * 64 + sch * 8;
    const int n1 = qt + 1, lo2 = (qt > 8 ? qt - 8 : 0), total = n1 + (qt - lo2 + 1);
    LAS char* kdst = lds + L_K + skey * KPB + sch * 16; LAS char* vdst = lds + L_V + skey * VPB + sch * 16;
    float negm = 0.f; f32x16 o[2], lacc;
#pragma unroll
    for (int i = 0; i < 16; ++i) { o[0][i] = 0.f; o[1][i] = 0.f; lacc[i] = 0.f; }
#define NSA_LOAD(j, kr, vr) do { const int jl_ = (j); if (jl_ < total) { const bool wl_ = jl_ >= n1; const int ktl_ = wl_ ? lo2 + (jl_ - n1) : jl_; \
        const bf16* pl_ = rowp + (size_t)ktl_ * 64 * ZP + (wl_ ? C_KW : C_KS); kr = *(const v4u*)pl_; vr = *(const v4u*)(pl_ + (C_VS - C_KS)); } } while (0)
#define NSA_FLUSH(gate_) do { const float sc_ = (gate_) * __builtin_amdgcn_rcpf(lacc[0]); \
        _Pragma("unroll") for (int db = 0; db < 2; ++db) _Pragma("unroll") for (int i4 = 0; i4 < 4; ++i4) { LAS f32x4* sp = (LAS f32x4*)(stash + (db * 4 + i4) * 1024); f32x4 y = *sp; \
            y.x = fmaf(sc_, o[db][4 * i4], y.x); y.y = fmaf(sc_, o[db][4 * i4 + 1], y.y); y.z = fmaf(sc_, o[db][4 * i4 + 2], y.z); y.w = fmaf(sc_, o[db][4 * i4 + 3], y.w); *sp = y; } } while (0)
#define NSA_STEP(j, kr, vr, bufi) do { const int j_ = (j); \
        if (j_ == n1) { NSA_FLUSH(g_s); negm = 0.f; _Pragma("unroll") for (int i = 0; i < 16; ++i) { o[0][i] = 0.f; o[1][i] = 0.f; lacc[i] = 0.f; } } \
        *(LAS v4u*)(kdst + (bufi) * KBUF) = kr; *(LAS v4u*)(vdst + (bufi) * VBUF) = vr; \
        asm volatile("s_waitcnt lgkmcnt(0)\n\ts_barrier" ::: "memory");     \
        NSA_LOAD(j_ + 2, kr, vr); \
        const bool w_ = j_ >= n1; const int kt_ = w_ ? lo2 + (j_ - n1) : j_; \
        const bool first_ = (j_ == 0) || (j_ == n1); \
        const bool rowok_ = w_ ? true : (((selmask >> kt_) & 1u) != 0u); \
        const bool gen_ = (kt_ >= qt - 2) || (w_ && kt_ == qt - 8); \
        const int dq_ = tq - kt_ * 64; \
        if (gen_) tile_step<1, true>(lds + L_K + (bufi) * KBUF, lds + L_V + (bufi) * VBUF, qf, negm, o, lacc, first_, rowok_, bfar, dq_, w_ ? 512 : 0x7fffffff, biasr, lane); \
        else tile_step<1, false>(lds + L_K + (bufi) * KBUF, lds + L_V + (bufi) * VBUF, qf, negm, o, lacc, first_, rowok_, bfar, dq_, 0, biasr, lane); } while (0)
    static_assert(C_VS - C_KS == C_VW - C_KW, "K -> V column offset is the same for both branches");
    v4u kA, vA, kB, vB;
    NSA_LOAD(0, kA, vA); NSA_LOAD(1, kB, vB);
#pragma unroll 1
    for (int j = 0; j < total; j += 2) {
        NSA_STEP(j, kA, vA, 0);
        if (j + 1 < total) NSA_STEP(j + 1, kB, vB, 1);
    }
    NSA_FLUSH(g_w);
    __syncthreads();
#undef NSA_LOAD
#undef NSA_FLUSH
#undef NSA_STEP
}

__device__ __forceinline__ void unit(LAS char* lds, const Tens& T, int b, int g, int qt) {
    int tid = threadIdx.x; asm volatile("" : "+v"(tid));
    const int lane = tid & 63, wid = __builtin_amdgcn_readfirstlane(tid >> 6);
    const int r = wid >> 1, qh = wid & 1, r32 = lane & 31, hh = lane >> 5;
    const int t0 = qt * 64, tq = t0 + qh * 32 + r32, head = g * 4 + r;
    const size_t zrow = (size_t)(b * SEQ + tq) * ZP;
    LAS float* BIAS = (LAS float*)(lds + L_BIAS);
    LAS float* IMPV = (LAS float*)(lds + L_IMPV);
    LAS unsigned* SEL = (LAS unsigned*)(lds + L_SEL);
    LAS float* SSQ = (LAS float*)(lds + L_SSQ);
    { const int rr = tid >> 7, d = tid & 127; BIAS[tid] = T.relb[t5_bucket(d) * 16 + g * 4 + rr] * LOG2E; }
    bf16x8 qf[4];
#pragma unroll
    for (int d0 = 0; d0 < 4; ++d0) { const v4u w = *(const v4u*)(T.z + zrow + C_Q + head * 64 + d0 * 16 + hh * 8);
        v4u qs; qs.x = cvtpk(bflo(w.x) * C1, bfhi(w.x) * C1); qs.y = cvtpk(bflo(w.y) * C1, bfhi(w.y) * C1); qs.z = cvtpk(bflo(w.z) * C1, bfhi(w.z) * C1); qs.w = cvtpk(bflo(w.w) * C1, bfhi(w.w) * C1);
        qf[d0] = __builtin_bit_cast(bf16x8, qs); }
    const float g_c = sigmoidf_(bf2f(T.z[zrow + C_GT + head * 3 + 0])), g_s = sigmoidf_(bf2f(T.z[zrow + C_GT + head * 3 + 1])), g_w = sigmoidf_(bf2f(T.z[zrow + C_GT + head * 3 + 2]));
    f32x16 yacc[2];
#pragma unroll
    for (int i = 0; i < 16; ++i) { yacc[0][i] = 0.f; yacc[1][i] = 0.f; }
    const bool two = (qt >= 16);
    { const int skey = tid >> 3, sch = tid & 7;
      const bf16* kc = T.kcvc + (size_t)((b * 4 + g) * 128) * 64, *vc = kc + (size_t)64 * 128 * 64;
      const int nt = two ? 2 : 1;
      for (int tt = 0; tt < nt; ++tt) {
          *(LAS v4u*)(lds + L_K + tt * KBUF + skey * KPB + sch * 16) = *(const v4u*)(kc + (size_t)(tt * 64 + skey) * 64 + sch * 8);
          *(LAS v4u*)(lds + L_V + tt * VBUF + skey * VPB + sch * 16) = *(const v4u*)(vc + (size_t)(tt * 64 + skey) * 64 + sch * 8);
      } }
    LAS unsigned* PSUMU = (LAS unsigned*)(lds + L_PSUM);
    if (two) { for (int u = tid; u < 128 * 65; u += 512) PSUMU[u] = 0u; }
    __syncthreads();
    const LAS float* biasr = BIAS + r * 128; const float bfar = biasr[127];
    { const int nt = two ? 2 : 1;
      float negm = 0.f; f32x16 o[2], lacc;
#pragma unroll
      for (int i = 0; i < 16; ++i) { o[0][i] = 0.f; o[1][i] = 0.f; lacc[i] = 0.f; }
#pragma unroll 1
      for (int tt = 0; tt < nt; ++tt)
          tile_step<16, true>(lds + L_K + tt * KBUF, lds + L_V + tt * VBUF, qf, negm, o, lacc, tt == 0, true, bfar, tq - 31 - tt * 1024, 0x7fffffff, biasr, lane);
      const float lsum = lacc[0];
      const float sc = (tq >= 31) ? g_c * __builtin_amdgcn_rcpf(lsum) : 0.f;
#pragma unroll
      for (int i = 0; i < 16; ++i) { yacc[0][i] = sc * o[0][i]; yacc[1][i] = sc * o[1][i]; }
      if (two) {
          const int qc = qh * 32 + r32; const float fx = 268435456.0f / lsum;
          f32x16 cin;
#pragma unroll
          for (int i = 0; i < 16; ++i) cin[i] = negm;
#pragma unroll 1
          for (int tt = 0; tt < 2; ++tt) {
              f32x16 a0, a1;
              qk_tile(a0, a1, lds + L_K + tt * KBUF, qf, cin, r32, hh);
              gen_fix<16>(a0, a1, tq - 31 - tt * 1024, 0x7fffffff, true, biasr, hh);
              LAS unsigned* pb = PSUMU + (tt * 64 + 4 * hh) * 65 + qc;
#pragma unroll
              for (int i = 0; i < 16; ++i) { const int ci = (i & 3) + 8 * (i >> 2);
                  __hip_atomic_fetch_add(pb + ci * 65, (unsigned)(__builtin_amdgcn_exp2f(a0[i]) * fx + 0.5f), __ATOMIC_RELAXED, __HIP_MEMORY_SCOPE_WORKGROUP);
                  __hip_atomic_fetch_add(pb + (ci + 32) * 65, (unsigned)(__builtin_amdgcn_exp2f(a1[i]) * fx + 0.5f), __ATOMIC_RELAXED, __HIP_MEMORY_SCOPE_WORKGROUP); }
          }
      }
    }
    __syncthreads();
    if (two) {
#pragma unroll 1
        for (int ps = 0; ps < 4; ++ps) {
            const int q = ps * 16 + 2 * wid + hh, j = r32;
            const int dblk = qt - j;
            float v;
            if (j == 0 || (dblk >= 0 && dblk < 2)) v = 1.0e4f;
            else if (dblk < 0) v = -1.0e4f;
            else { const LAS unsigned* pc = PSUMU + (4 * j) * 65 + q; v = ((float)pc[-65] + 2.f * (float)pc[0] + 2.f * (float)pc[65] + 2.f * (float)pc[130] + (float)pc[195]) * (1.0f / 268435456.0f); }
            IMPV[q * 32 + j] = v;
        }
        __syncthreads();
#pragma unroll 1
        for (int ps = 0; ps < 4; ++ps) {
            const int q = ps * 16 + 2 * wid + hh, j = r32;
            const float v = IMPV[q * 32 + j]; int rank = 0;
#pragma unroll
            for (int jj = 0; jj < 32; ++jj) { const float o = IMPV[q * 32 + jj]; rank += (o > v || (o == v && jj < j)) ? 1 : 0; }
            const unsigned long long bal = __ballot(rank < 16);
            if (r32 == 0) SEL[q] = hh ? (unsigned)(bal >> 32) : (unsigned)bal;
        }
        __syncthreads();
    }
    const unsigned selmask = two ? SEL[qh * 32 + r32] : 0xffffffffu;
    __syncthreads();
    LAS char* stash = lds + L_STASH + wid * 8192 + lane * 16;
#pragma unroll
    for (int db = 0; db < 2; ++db)
#pragma unroll
        for (int i4 = 0; i4 < 4; ++i4) *(LAS f32x4*)(stash + (db * 4 + i4) * 1024) = (f32x4){yacc[db][4 * i4], yacc[db][4 * i4 + 1], yacc[db][4 * i4 + 2], yacc[db][4 * i4 + 3]};
    branches(lds, T, b, g, qt, tq, qf, biasr, bfar, selmask, g_s, g_w, stash, tid, lane);
#pragma unroll
    for (int db = 0; db < 2; ++db)
#pragma unroll
        for (int i4 = 0; i4 < 4; ++i4) { const f32x4 y = *(const LAS f32x4*)(stash + (db * 4 + i4) * 1024); yacc[db][4 * i4] = y.x; yacc[db][4 * i4 + 1] = y.y; yacc[db][4 * i4 + 2] = y.z; yacc[db][4 * i4 + 3] = y.w; }
    { bf16* yp = T.y + (size_t)(b * SEQ + tq) * DM + LRUW + head * 64;
      float ss = 0.f;
#pragma unroll
      for (int db = 0; db < 2; ++db)
#pragma unroll
          for (int i4 = 0; i4 < 4; ++i4) {
              const float v0 = yacc[db][4 * i4], v1 = yacc[db][4 * i4 + 1], v2 = yacc[db][4 * i4 + 2], v3 = yacc[db][4 * i4 + 3];
              ss += (v0 * v0 + v1 * v1) + (v2 * v2 + v3 * v3);
              v2u w; w.x = cvtpk(v0, v1); w.y = cvtpk(v2, v3);
              *(v2u*)(yp + db * 32 + 8 * i4 + 4 * hh) = w;
          }
      ss += __shfl_xor(ss, 32);
      if (hh == 0) SSQ[r * 64 + qh * 32 + r32] = ss;
      __syncthreads();
      if (tid < 64) T.ssn[(size_t)(b * SEQ + t0 + tid) * 4 + g] = (SSQ[tid] + SSQ[64 + tid]) + (SSQ[128 + tid] + SSQ[192 + tid]);
      __syncthreads(); }
}
#undef NSA_MFMA
}
namespace lru {
constexpr int TC = 128;
constexpr int L_XF = 0, L_AF = 32768, L_XB = 65536, XBP = 144, L_SEG = L_XB + TC * XBP, L_CARRY = L_SEG + 4096, L_SQ = L_CARRY + 256, L_END = L_SQ + TC * 65 * 4;
static_assert(L_END <= RING_BYTES, "lru LDS");
typedef float f32x4_ __attribute__((ext_vector_type(4)));
struct Tens { const bf16* z; const float *conv_w, *conv_b, *wa, *ba, *wx, *bx, *lam; bf16* y; float* ssl; };

__device__ __forceinline__ void unit(LAS char* lds, const Tens& T, int b, int n) {
    const int tid = threadIdx.x, lane = tid & 63, w = __builtin_amdgcn_readfirstlane(tid >> 6);
    const int c = lane, ch = n * 64 + c;
    LAS float* XF = (LAS float*)(lds + L_XF); LAS float* AF = (LAS float*)(lds + L_AF);
    LAS float* SEGA = (LAS float*)(lds + L_SEG); LAS float* SEGH = SEGA + 512;
    LAS float* CARRY = (LAS float*)(lds + L_CARRY); LAS float* YSQ = (LAS float*)(lds + L_SQ);
    const float cw0 = T.conv_w[ch], cw1 = T.conv_w[1024 + ch], cw2 = T.conv_w[2048 + ch], cw3 = T.conv_w[3072 + ch], cb = T.conv_b[ch];
    bf16x8 fwa[4][2], fwx[4][2]; float bar[4], bxr[4], clc[4];
    { const int kq = lane >> 4, jc = lane & 15;
#pragma unroll
      for (int cb4 = 0; cb4 < 4; ++cb4) {
          const int col = 16 * cb4 + jc;
#pragma unroll
          for (int ks = 0; ks < 2; ++ks) {
              unsigned short ea[8], ex[8];
#pragma unroll
              for (int e = 0; e < 8; ++e) { const size_t o = (size_t)n * 4096 + (size_t)(8 * kq + e + 32 * ks) * 64 + col; ea[e] = (unsigned short)f2bf(T.wa[o]); ex[e] = (unsigned short)f2bf(T.wx[o]); }
              fwa[cb4][ks] = (bf16x8){(short)ea[0], (short)ea[1], (short)ea[2], (short)ea[3], (short)ea[4], (short)ea[5], (short)ea[6], (short)ea[7]};
              fwx[cb4][ks] = (bf16x8){(short)ex[0], (short)ex[1], (short)ex[2], (short)ex[3], (short)ex[4], (short)ex[5], (short)ex[6], (short)ex[7]};
          }
          bar[cb4] = T.ba[n * 64 + col]; bxr[cb4] = T.bx[n * 64 + col];
          const float lm = T.lam[n * 64 + col];
          clc[cb4] = -8.0f * log1pf(expf(-lm)) * LOG2E;
      } }
    if (tid < 64) CARRY[tid] = 0.f;
    const bf16* zu = T.z + (size_t)b * SEQ * ZP + C_U + ch;
    const bf16* zg = T.z + (size_t)b * SEQ * ZP + C_GL + ch;
#pragma unroll 1
    for (int chunk = 0; chunk < SEQ / TC; ++chunk) {
        const int tb = chunk * TC + 16 * w;
        unsigned short gl[16];
#pragma unroll
        for (int i = 0; i < 16; ++i) gl[i] = zg[(size_t)(tb + i) * ZP];
        float uu[19];
#pragma unroll
        for (int k = 0; k < 19; ++k) { const int t = tb - 3 + k; uu[k] = (t >= 0) ? bf2f(zu[(size_t)t * ZP]) : 0.f; }
#pragma unroll
        for (int i = 0; i < 16; ++i) {
            const float xc = cb + cw0 * uu[i] + cw1 * uu[i + 1] + cw2 * uu[i + 2] + cw3 * uu[i + 3];
            XF[(16 * w + i) * 64 + c] = xc;
            *(LAS unsigned short*)(lds + L_XB + (16 * w + i) * XBP + c * 2) = (unsigned short)f2bf(xc);
        }
        __syncthreads();
        { const int kq = lane >> 4, jc = lane & 15;
          const bf16x8 fa0 = *(const LAS bf16x8*)(lds + L_XB + (16 * w + jc) * XBP + (8 * kq) * 2), fa1 = *(const LAS bf16x8*)(lds + L_XB + (16 * w + jc) * XBP + (8 * kq + 32) * 2);
#pragma unroll
          for (int cb4 = 0; cb4 < 4; ++cb4) {
              f32x4_ ar = {0.f, 0.f, 0.f, 0.f}, ax = {0.f, 0.f, 0.f, 0.f};
              ar = __builtin_amdgcn_mfma_f32_16x16x32_bf16(fa0, fwa[cb4][0], ar, 0, 0, 0); ar = __builtin_amdgcn_mfma_f32_16x16x32_bf16(fa1, fwa[cb4][1], ar, 0, 0, 0);
              ax = __builtin_amdgcn_mfma_f32_16x16x32_bf16(fa0, fwx[cb4][0], ax, 0, 0, 0); ax = __builtin_amdgcn_mfma_f32_16x16x32_bf16(fa1, fwx[cb4][1], ax, 0, 0, 0);
              const int col = 16 * cb4 + jc;
#pragma unroll
              for (int e = 0; e < 4; ++e) {
                  const int tt = 16 * w + 4 * kq + e;
                  const float rg = sigmoidf_(ar[e] + bar[cb4]), ig = sigmoidf_(ax[e] + bxr[cb4]);
                  const float a = __builtin_amdgcn_exp2f(clc[cb4] * rg);
                  const float xcv = XF[tt * 64 + col];
                  AF[tt * 64 + col] = a;
                  XF[tt * 64 + col] = __builtin_amdgcn_sqrtf(fmaxf(1.0f - a * a, 0.f)) * (ig * xcv);
              }
          } }
        __syncthreads();
        float av[16], bv[16];
#pragma unroll
        for (int i = 0; i < 16; ++i) { av[i] = AF[(16 * w + i) * 64 + c]; bv[i] = XF[(16 * w + i) * 64 + c]; }
        { float A = 1.f, H = 0.f;
#pragma unroll
          for (int i = 0; i < 16; ++i) { H = av[i] * H + bv[i]; A *= av[i]; }
          SEGA[w * 64 + c] = A; SEGH[w * 64 + c] = H; }
        __syncthreads();
        float h = CARRY[c];
        for (int s = 0; s < w; ++s) h = SEGA[s * 64 + c] * h + SEGH[s * 64 + c];
        bf16* yp = T.y + (size_t)(b * SEQ + tb) * DM + ch;
#pragma unroll
        for (int i = 0; i < 16; ++i) {
            h = av[i] * h + bv[i];
            const float yv = h * pg8::gelu_tanh(bf2f(gl[i]));
            yp[(size_t)i * DM] = (bf16)f2bf(yv);
            YSQ[(16 * w + i) * 65 + c] = yv * yv;
        }
        __syncthreads();
        if (w == 7) CARRY[c] = h;
        if (tid < TC) { float s = 0.f;
#pragma unroll 8
            for (int k = 0; k < 64; ++k) s += YSQ[tid * 65 + k];
            T.ssl[(size_t)(b * SEQ + chunk * TC + tid) * 16 + n] = s; }
    }
    __syncthreads();
}
}
struct Frame {
    LAS unsigned char* lds; volatile LAS unsigned* MISC; gu32* ctl;
    int tid, lane, wave, vcu, G;
};
struct Args { const float* in[28]; float* out; unsigned char* ws; int ph_lo, ph_hi; };

__device__ __forceinline__ void p0_transpose_item(const float* W, int K, int N, int NP, bf16* WT, LAS float* scr, int item, int lane, const float* kscale = nullptr) {
    const int nblk = NP / 32, kb = item / nblk, nb = item % nblk, k0 = 64 * kb, n0 = 32 * nb;
    const int nn = n0 + (lane & 31);
#pragma unroll 8
    for (int i = 0; i < 32; ++i) { const int kk = 2 * i + (lane >> 5); float v = (nn < N) ? W[(size_t)(k0 + kk) * N + nn] : 0.f; if (kscale) v *= kscale[k0 + kk]; scr[kk * 33 + (lane & 31)] = v; }
    LDS_WAIT(); asm volatile("" ::: "memory");
    const int c = lane & 7;
#pragma unroll
    for (int j = 0; j < 4; ++j) { const int n = (lane >> 3) + 8 * j; const LAS float* s = scr + (8 * c) * 33 + n;
        v4u o; o.x = pk2(s[0 * 33], s[1 * 33]); o.y = pk2(s[2 * 33], s[3 * 33]); o.z = pk2(s[4 * 33], s[5 * 33]); o.w = pk2(s[6 * 33], s[7 * 33]);
        *(GAS v4u*)(WT + (size_t)(n0 + n) * K + k0 + 8 * c) = o; }
    LDS_WAIT(); asm volatile("" ::: "memory");
}
__device__ __forceinline__ void rms_row_to_bf16(const float* xrow, const float* g, bf16* orow, int lane) {
    f32x4 v[8]; float s = 0.f;
#pragma unroll
    for (int j = 0; j < 8; ++j) { v[j] = *(const f32x4*)(xrow + 4 * (lane + 64 * j)); s += (v[j].x * v[j].x + v[j].y * v[j].y) + (v[j].z * v[j].z + v[j].w * v[j].w); }
    const float rs = 1.0f / sqrtf(wave_sum(s) * (1.0f / DM) + NORM_EPS);
#pragma unroll
    for (int j = 0; j < 8; ++j) { const f32x4 gg = *(const f32x4*)(g + 4 * (lane + 64 * j)); v2u o; o.x = pk2(v[j].x * rs * gg.x, v[j].y * rs * gg.y); o.y = pk2(v[j].z * rs * gg.z, v[j].w * rs * gg.w);
        *(v2u*)(orow + 4 * (lane + 64 * j)) = o; }
}

__global__ void __launch_bounds__(NWAVES * 64, 2) hymba_fwd(Args args) {
    extern __shared__ __attribute__((aligned(16))) unsigned char lds[];
    Frame F;
    F.lds = (LAS unsigned char*)lds; F.MISC = (volatile LAS unsigned*)(F.lds + MISC_OFF);
    F.tid = threadIdx.x; F.lane = F.tid & 63; F.wave = __builtin_amdgcn_readfirstlane(F.tid >> 6);
    F.G = gridDim.x; { const int bx = blockIdx.x; F.vcu = (F.G % 8 == 0) ? (bx % 8) * (F.G / 8) + bx / 8 : bx; }
    unsigned char* ws = args.ws;
    F.ctl = (gu32*)(ws + WS_CTL);
    for (int u = F.tid; u < (LDS_BYTES - LDSCTL_OFF) / 4; u += NWAVES * 64) ((LAS unsigned*)(F.lds + LDSCTL_OFF))[u] = 0u;
    __syncthreads();
    XcdBarrier bar = xcd_barrier_post((unsigned*)(F.ctl + CW_BAR), F.MISC + 8);
    const int lo = args.ph_lo, hi = args.ph_hi;
#ifndef PHMASK
#define PHMASK 0xfff
#endif
#define IN(k) (((PHMASK >> (k)) & 1) && lo <= (k) && (k) < hi)
#ifndef REP_MASK
#define REP_MASK 0
#endif
#ifndef PROBE_MODE
#define PROBE_MODE 0
#endif
#ifndef PROBE_PH
#define PROBE_PH 8
#endif
#define TS ((volatile LAS unsigned long long*)(LDSCTL_OFF + 1024))
#define STAMP(k) do { if (PROBE_MODE && blockIdx.x == 0 && F.tid == 0) { TS[2 * (k)] = __builtin_amdgcn_s_memrealtime(); TS[2 * (k) + 1] = (unsigned long long)clock64(); } } while (0)
#define PH_BEGIN(k) if (IN(k)) { STAMP(k); for (int rep_ = 0; rep_ < ((REP_MASK >> (k)) & 1) + 1; ++rep_) { if (rep_) xcd_barrier(bar);
#define PH_END() } }
#define SEAM(k) do { if (IN(k) && IN((k) + 1)) xcd_barrier(bar); } while (0)
#define x_in (args.in[0])
#define p_in (args.in[1])
#define g_mix_pre (args.in[2])
#define g_mix_post (args.in[3])
#define g_mlp_pre (args.in[4])
#define g_mlp_post (args.in[5])
#define w_in (args.in[6])
#define conv_w (args.in[7])
#define conv_b (args.in[8])
#define lru_wa (args.in[9])
#define lru_ba (args.in[10])
#define lru_wx (args.in[11])
#define lru_bx (args.in[12])
#define lru_lam (args.in[13])
#define pe_k (args.in[14])
#define cw1_k (args.in[15])
#define cw2_k (args.in[16])
#define pe_v (args.in[17])
#define cw1_v (args.in[18])
#define cw2_v (args.in[19])
#define rel_bias (args.in[20])
#define gn_lru (args.in[21])
#define gn_nsa (args.in[22])
#define w_out (args.in[23])
#define mlp_w1 (args.in[24])
#define mlp_w2 (args.in[25])
#define ple_gate (args.in[26])
#define ple_proj (args.in[27])
    float* out = args.out;
    bf16 *Win_t = (bf16*)(ws + WS_WIN), *Wout_t = (bf16*)(ws + WS_WOUT), *W1_t = (bf16*)(ws + WS_W1), *W2_t = (bf16*)(ws + WS_W2), *Wg_t = (bf16*)(ws + WS_WG), *Wp_t = (bf16*)(ws + WS_WP);
    bf16 *Cw1k_t = (bf16*)(ws + WS_CW1K), *Cw1v_t = (bf16*)(ws + WS_CW1V);
    float* b1part = (float*)(ws + WS_MISC); float* bias1 = (float*)(ws + WS_MISC + 65536); float* RS = (float*)(ws + WS_MISC + 131072);
    bf16* PB = (bf16*)(ws + WS_PB); bf16* HID = (bf16*)(ws + WS_HID); bf16* KCVC = (bf16*)(ws + WS_KCVC);
    float *SSL = (float*)(ws + WS_SSL), *SSN = (float*)(ws + WS_SSN), *SSQ = (float*)(ws + WS_SSQ);
    bf16 *A = (bf16*)(ws + WS_A), *Z = (bf16*)(ws + WS_Z), *Y = (bf16*)(ws + WS_Y), *TT = (bf16*)(ws + WS_T), *HID2 = (bf16*)(ws + WS_HID2), *FF = (bf16*)(ws + WS_F), *PP = (bf16*)(ws + WS_PP);
    const int gw = F.vcu * NWAVES + F.wave, NGW = F.G * NWAVES;

    PH_BEGIN(0)
        LAS float* scr = (LAS float*)(F.lds + RING_OFF + F.wave * 16384);
        constexpr int I_IN = (DM / 64) * (ZP / 32), I_OUT = (DM / 64) * (DM / 32), I_1 = (DM / 64) * (DFF / 32), I_2 = (DFF / 64) * (DM / 32), I_G = I_OUT, I_P = (PLE / 64) * (DM / 32), I_C = (CMP_K / 64) * (CMP_H / 32);
        constexpr int NITEMS = I_IN + I_OUT + I_1 + I_2 + I_G + I_P + 2 * I_C;
        for (int it = gw; it < NITEMS; it += NGW) {
            int r = it;
            if (r < I_IN) { p0_transpose_item(w_in, DM, IN_DIM, ZP, Win_t, scr, r, F.lane); continue; } r -= I_IN;
            if (r < I_OUT) { p0_transpose_item(w_out, DM, DM, DM, Wout_t, scr, r, F.lane); continue; } r -= I_OUT;
            if (r < I_1) { p0_transpose_item(mlp_w1, DM, DFF, DFF, W1_t, scr, r, F.lane, g_mlp_pre); continue; } r -= I_1;
            if (r < I_2) { p0_transpose_item(mlp_w2, DFF, DM, DM, W2_t, scr, r, F.lane); continue; } r -= I_2;
            if (r < I_G) { p0_transpose_item(ple_gate, DM, DM, DM, Wg_t, scr, r, F.lane); continue; } r -= I_G;
            if (r < I_P) { p0_transpose_item(ple_proj, PLE, DM, DM, Wp_t, scr, r, F.lane); continue; } r -= I_P;
            if (r < I_C) { p0_transpose_item(cw1_k, CMP_K, CMP_H, CMP_H, Cw1k_t, scr, r, F.lane); continue; } r -= I_C;
            p0_transpose_item(cw1_v, CMP_K, CMP_H, CMP_H, Cw1v_t, scr, r, F.lane);
        }
        for (int m = gw; m < MTOK; m += NGW) rms_row_to_bf16(x_in + (size_t)m * DM, g_mix_pre, A + (size_t)m * DM, F.lane);
        for (int m = gw; m < MTOK; m += NGW) { const f32x4 v = *(const f32x4*)(p_in + (size_t)m * PLE + 4 * F.lane); v2u o; o.x = pk2(v.x, v.y); o.y = pk2(v.z, v.w); *(v2u*)(PB + (size_t)m * PLE + 4 * F.lane) = o; }
        for (int it = gw; it < 256; it += NGW) {
            const int ten = it >> 7, ks = (it >> 3) & 15, cg = it & 7, col = cg * 32 + (F.lane & 31), kh = F.lane >> 5;
            const float* pe = ten ? pe_v : pe_k; const float* w1 = ten ? cw1_v : cw1_k; float s = 0.f;
            for (int k = 0; k < 64; ++k) { const int kk = ks * 128 + kh * 64 + k; s += pe[kk] * w1[(size_t)kk * CMP_H + col]; }
            s += __shfl_xor(s, 32);
            if (kh == 0) b1part[(ten * 16 + ks) * 256 + col] = s;
        }
    PH_END()
    SEAM(0);
    PH_BEGIN(1)
        if (blockIdx.x == 0) { const int ten = F.tid >> 8, col = F.tid & 255; float s = 0.f;
            for (int ks = 0; ks < 16; ++ks) s += b1part[(ten * 16 + ks) * 256 + col];
            bias1[ten * 256 + col] = s; }
        pg8::Gemm g{A, Win_t, MTOK, ZP, DM}; pg8::StaticOrder S; S.init(MTOK, ZP, F.G, (int)blockIdx.x);
        pg8::EpiAct<0> E{Z, ZP, nullptr, nullptr};
        pg8::gemm_phase<pg8::EpiAct<0>, pg8::StaticOrder, pg8::AMapPlain, true, true>(F.lds + RING_OFF, g, S, E);
    PH_END()
    SEAM(1);
    PH_BEGIN(2)
        { lru::Tens T{Z, conv_w, conv_b, lru_wa, lru_ba, lru_wx, lru_bx, lru_lam, Y, SSL};
          for (int u = F.vcu; u < BATCH * 16; u += F.G) lru::unit((LAS char*)F.lds, T, u >> 4, u & 15); }
        { pg8::Gemm g{Z + C_KC, Cw1k_t, 8192, CMP_H, CMP_K}; pg8::StaticOrder S; S.init(8192, CMP_H, F.G, (int)blockIdx.x);
          pg8::EpiAct<2> E{HID, CMP_H, bias1, nullptr};
          pg8::gemm_phase<pg8::EpiAct<2>, pg8::StaticOrder, pg8::AMapCmp, false, true>(F.lds + RING_OFF, g, S, E); }
        __syncthreads();
        { pg8::Gemm g{Z + C_VC, Cw1v_t, 8192, CMP_H, CMP_K}; pg8::StaticOrder S; S.init(8192, CMP_H, F.G, (int)((blockIdx.x + 128) % F.G));
          pg8::EpiAct<2> E{HID + (size_t)8192 * CMP_H, CMP_H, bias1 + 256, nullptr};
          pg8::gemm_phase<pg8::EpiAct<2>, pg8::StaticOrder, pg8::AMapCmp, false, true>(F.lds + RING_OFF, g, S, E); }
    PH_END()
    SEAM(2);
    PH_BEGIN(3)
        for (int it = F.vcu * 512 + F.tid; it < 2 * 8192 * 8; it += F.G * 512) {
            const int row = it >> 3, c8 = it & 7, ten = row >> 13;
            const float* w2 = (ten ? cw2_v : cw2_k) + c8 * 8;
            float acc[8] = {0.f, 0.f, 0.f, 0.f, 0.f, 0.f, 0.f, 0.f};
            if ((row & 127) != 127) {
                const bf16* hp = HID + (size_t)row * CMP_H;
                for (int k8 = 0; k8 < 32; ++k8) {
                    const v4u hw = *(const v4u*)(hp + k8 * 8); const unsigned hu[4] = {hw.x, hw.y, hw.z, hw.w};
#pragma unroll
                    for (int e = 0; e < 8; ++e) { const float hv = (e & 1) ? bfhi(hu[e >> 1]) : bflo(hu[e >> 1]);
                        const f32x4 wa = *(const f32x4*)(w2 + (size_t)(k8 * 8 + e) * 64), wb = *(const f32x4*)(w2 + (size_t)(k8 * 8 + e) * 64 + 4);
                        acc[0] += hv * wa.x; acc[1] += hv * wa.y; acc[2] += hv * wa.z; acc[3] += hv * wa.w; acc[4] += hv * wb.x; acc[5] += hv * wb.y; acc[6] += hv * wb.z; acc[7] += hv * wb.w; }
                }
            }
            v4u o; o.x = pk2(acc[0], acc[1]); o.y = pk2(acc[2], acc[3]); o.z = pk2(acc[4], acc[5]); o.w = pk2(acc[6], acc[7]);
            *(v4u*)(KCVC + (size_t)row * 64 + c8 * 8) = o;
        }
    PH_END()
    SEAM(3);
    PH_BEGIN(4)
        nsa::Tens T{Z, KCVC, rel_bias, Y, SSN};
        for (int v = F.vcu; v < 256; v += F.G) {
            const int bg = v >> 2, k = v & 3;
#pragma unroll 1
            for (int i = 7; i >= 0; --i) { const int qt = 8 * (i >> 1) + ((i & 1) ? 7 - k : k); nsa::unit((LAS char*)F.lds, T, bg >> 2, bg & 3, qt); }
        }
    PH_END()
    SEAM(4);
    PH_BEGIN(5)
        for (int m = gw; m < MTOK; m += NGW) {
            float sl = (F.lane < 16) ? SSL[(size_t)m * 16 + F.lane] : 0.f, sn = (F.lane < 4) ? SSN[(size_t)m * 4 + F.lane] : 0.f;
            sl = wave_sum(sl); sn = wave_sum(sn);
            const float rl = 1.0f / sqrtf(sl * (1.0f / 1024.f) + NORM_EPS), rn = 1.0f / sqrtf(sn * (1.0f / 1024.f) + NORM_EPS);
            bf16* yr = Y + (size_t)m * DM;
#pragma unroll
            for (int j = 0; j < 4; ++j) { const int c0 = 8 * (F.lane + 64 * j); const float rs = (j < 2) ? rl : rn; const float* gp = (j < 2) ? (gn_lru + c0) : (gn_nsa + c0 - 1024);
                const v4u w = *(const v4u*)(yr + c0); const f32x4 g0 = *(const f32x4*)gp, g1 = *(const f32x4*)(gp + 4);
                v4u o; o.x = pk2(bflo(w.x) * rs * g0.x, bfhi(w.x) * rs * g0.y); o.y = pk2(bflo(w.y) * rs * g0.z, bfhi(w.y) * rs * g0.w);
                o.z = pk2(bflo(w.z) * rs * g1.x, bfhi(w.z) * rs * g1.y); o.w = pk2(bflo(w.w) * rs * g1.z, bfhi(w.w) * rs * g1.w);
                *(v4u*)(yr + c0) = o; }
        }
    PH_END()
    SEAM(5);
    PH_BEGIN(6)
        pg8::Gemm g{Y, Wout_t, MTOK, DM, DM}; pg8::StaticOrder S; S.init(MTOK, DM, F.G, (int)blockIdx.x);
        pg8::EpiSsq E{TT, DM, SSQ};
        pg8::gemm_phase<pg8::EpiSsq, pg8::StaticOrder, pg8::AMapPlain, true, true>(F.lds + RING_OFF, g, S, E);
    PH_END()
    SEAM(6);
    PH_BEGIN(7)
        for (int m = gw; m < MTOK; m += NGW) {
            float sq = (F.lane < 32) ? SSQ[(size_t)m * 32 + F.lane] : 0.f; sq = wave_sum(sq);
            const float rt = 1.0f / sqrtf(sq * (1.0f / DM) + NORM_EPS);
            const bf16* tr = TT + (size_t)m * DM; const float* xr = x_in + (size_t)m * DM; bf16* ar = A + (size_t)m * DM;
            float s2 = 0.f;
#pragma unroll
            for (int j = 0; j < 4; ++j) { const int c0 = 8 * (F.lane + 64 * j);
                const v4u w = *(const v4u*)(tr + c0); const f32x4 x0 = *(const f32x4*)(xr + c0), x1 = *(const f32x4*)(xr + c0 + 4), g0 = *(const f32x4*)(g_mix_post + c0), g1 = *(const f32x4*)(g_mix_post + c0 + 4);
                f32x4 h0, h1;
                h0.x = x0.x + bflo(w.x) * rt * g0.x; h0.y = x0.y + bfhi(w.x) * rt * g0.y; h0.z = x0.z + bflo(w.y) * rt * g0.z; h0.w = x0.w + bfhi(w.y) * rt * g0.w;
                h1.x = x1.x + bflo(w.z) * rt * g1.x; h1.y = x1.y + bfhi(w.z) * rt * g1.y; h1.z = x1.z + bflo(w.w) * rt * g1.z; h1.w = x1.w + bfhi(w.w) * rt * g1.w;
                s2 += (h0.x * h0.x + h0.y * h0.y) + (h0.z * h0.z + h0.w * h0.w); s2 += (h1.x * h1.x + h1.y * h1.y) + (h1.z * h1.z + h1.w * h1.w);
                v4u o; o.x = pk2(h0.x, h0.y); o.y = pk2(h0.z, h0.w); o.z = pk2(h1.x, h1.y); o.w = pk2(h1.z, h1.w);
                *(v4u*)(ar + c0) = o; }
            s2 = wave_sum(s2);
            if (F.lane == 0) RS[m] = 1.0f / sqrtf(s2 * (1.0f / DM) + NORM_EPS);
        }
    PH_END()
    SEAM(7);
    PH_BEGIN(8)
        pg8::Gemm g{A, W1_t, MTOK, DFF, DM}; pg8::StaticOrder S; S.init(MTOK, DFF, F.G, (int)blockIdx.x);
        pg8::EpiAct<3> E{HID2, DFF, nullptr, RS};
        pg8::gemm_phase<pg8::EpiAct<3>, pg8::StaticOrder, pg8::AMapPlain, true, true>(F.lds + RING_OFF, g, S, E);
    PH_END()
    SEAM(8);
    PH_BEGIN(9)
        pg8::Gemm g{HID2, W2_t, MTOK, DM, DFF}; pg8::StaticOrder S; S.init(MTOK, DM, F.G, (int)blockIdx.x);
        pg8::EpiSsq E{FF, DM, SSQ};
        pg8::gemm_phase<pg8::EpiSsq, pg8::StaticOrder, pg8::AMapPlain, true, true>(F.lds + RING_OFF, g, S, E);
    PH_END()
    SEAM(9);
    PH_BEGIN(10)
        for (int m = gw; m < MTOK; m += NGW) {
            float sq = (F.lane < 32) ? SSQ[(size_t)m * 32 + F.lane] : 0.f; sq = wave_sum(sq);
            const float rf = 1.0f / sqrtf(sq * (1.0f / DM) + NORM_EPS);
            const bf16* fr_ = FF + (size_t)m * DM; bf16* ar = A + (size_t)m * DM;
#pragma unroll
            for (int j = 0; j < 4; ++j) { const int c0 = 8 * (F.lane + 64 * j);
                const v4u w = *(const v4u*)(fr_ + c0), hw = *(const v4u*)(ar + c0); const f32x4 g0 = *(const f32x4*)(g_mlp_post + c0), g1 = *(const f32x4*)(g_mlp_post + c0 + 4);
                v4u o; o.x = pk2(bflo(hw.x) + bflo(w.x) * rf * g0.x, bfhi(hw.x) + bfhi(w.x) * rf * g0.y); o.y = pk2(bflo(hw.y) + bflo(w.y) * rf * g0.z, bfhi(hw.y) + bfhi(w.y) * rf * g0.w);
                o.z = pk2(bflo(hw.z) + bflo(w.z) * rf * g1.x, bfhi(hw.z) + bfhi(w.z) * rf * g1.y); o.w = pk2(bflo(hw.w) + bflo(w.w) * rf * g1.z, bfhi(hw.w) + bfhi(w.w) * rf * g1.w);
                *(v4u*)(ar + c0) = o; }
        }
        VM_WAIT(); __syncthreads();
        int kple = PLE; asm volatile("" : "+s"(kple));
        pg8::Gemm g{PB, Wp_t, MTOK, DM, kple}; pg8::StaticOrder S; S.init(MTOK, DM, F.G, (int)blockIdx.x);
        pg8::EpiAct<0> E{PP, DM, nullptr, nullptr};
        pg8::gemm_phase<pg8::EpiAct<0>, pg8::StaticOrder, pg8::AMapPlain, true, true>(F.lds + RING_OFF, g, S, E);
    PH_END()
    SEAM(10);
    PH_BEGIN(11)
        pg8::Gemm g{A, Wg_t, MTOK, DM, DM}; pg8::StaticOrder S; S.init(MTOK, DM, F.G, (int)blockIdx.x);
        pg8::EpiGate E{out, A, PP, DM};
        pg8::gemm_phase<pg8::EpiGate, pg8::StaticOrder, pg8::AMapPlain, true, true>(F.lds + RING_OFF, g, S, E);
    PH_END()
#if PROBE_MODE
    STAMP(12);
    if (blockIdx.x == 0 && F.tid == 0) {
        const unsigned long long r0 = TS[2 * PROBE_PH], r1 = TS[2 * PROBE_PH + 2], c0 = TS[2 * PROBE_PH + 1], c1 = TS[2 * PROBE_PH + 3];
        unsigned long long ticks;
        if (PROBE_MODE == 1) ticks = (c1 - c0) * 100ull / (r1 - r0) * 100ull;
        else ticks = (r1 - r0) * (unsigned long long)(PROBE_MODE - 1);
        const unsigned long long t0 = __builtin_amdgcn_s_memrealtime();
        while (__builtin_amdgcn_s_memrealtime() - t0 < ticks) __builtin_amdgcn_s_sleep(8);
    }
#endif
#undef IN
#undef SEAM
#undef x_in
#undef p_in
}

#ifndef MK_SPLIT
#define MK_SPLIT 0
#endif
extern "C" void kernel_launch(void* const* d_in, const int* in_sizes, int n_in, void* d_out, int out_size, void* d_ws, size_t ws_size, hipStream_t stream) {
    static int grid = 0;
    if (grid == 0) {
        if (n_in != 28 || out_size != MTOK * DM || ws_size < WS_END) { fprintf(stderr, "kernel_launch: unexpected shapes (n_in %d, out %d, ws %zu)\n", n_in, out_size, ws_size); grid = -1; return; }
        int dev = 0, cus = 0, per_cu = 0;
        if (hipGetDevice(&dev) != hipSuccess || hipDeviceGetAttribute(&cus, hipDeviceAttributeMultiprocessorCount, dev) != hipSuccess) { grid = -1; return; }
        if (hipFuncSetAttribute((const void*)hymba_fwd, hipFuncAttributeMaxDynamicSharedMemorySize, LDS_BYTES) != hipSuccess) { fprintf(stderr, "kernel_launch: hipFuncSetAttribute failed\n"); grid = -1; return; }
        if (hipOccupancyMaxActiveBlocksPerMultiprocessor(&per_cu, (const void*)hymba_fwd, NWAVES * 64, LDS_BYTES) != hipSuccess || per_cu < 1) { fprintf(stderr, "kernel_launch: occupancy query says %d\n", per_cu); (void)hipGetLastError(); }
        grid = cus;
    }
    if (grid < 0) return;
    (void)hipMemsetAsync((char*)d_ws + WS_CTL, 0, CTL_ZERO_BYTES, stream);
    Args a{};
    for (int i = 0; i < 28; ++i) a.in[i] = (const float*)d_in[i];
    a.out = (float*)d_out; a.ws = (unsigned char*)d_ws;
#if MK_SPLIT
    for (int ph = 0; ph < 12; ++ph) { a.ph_lo = ph; a.ph_hi = ph + 1; hipLaunchKernelGGL(hymba_fwd, dim3(grid), dim3(NWAVES * 64), LDS_BYTES, stream, a); }
#else
    a.ph_lo = 0; a.ph_hi = 12;
    hipLaunchKernelGGL(hymba_fwd, dim3(grid), dim3(NWAVES * 64), LDS_BYTES, stream, a);
#endif
}
```

```cpp
#include <hip/hip_runtime.h>
#include <cstdio>
#include <cstdint>

constexpr int BATCH = 16, SEQ = 2048, DM = 2048, MTOK = BATCH * SEQ;
constexpr int IN_DIM = 4656, ZP = 4864;
constexpr int C_U = 0, C_GL = 1024, C_Q = 2048, C_KC = 3072, C_VC = 3328, C_KS = 3584, C_VS = 3840, C_KW = 4096, C_VW = 4352, C_GT = 4608;
constexpr int DFF = 8192, PLE = 256, LRUW = 1024, NHEAD = 16, HD = 64, NKV = 4;
constexpr int NCMP = 127, NCMP_P = 128, CMP_K = 2048, CMP_H = 256;
constexpr float NORM_EPS = 1e-6f;
constexpr float LOG2E = 1.4426950408889634f;

namespace pg8 {
#define PG8_LAS __attribute__((address_space(3)))
typedef unsigned short bf16_t;
typedef short bf16x8 __attribute__((ext_vector_type(8)));
typedef float f32x4 __attribute__((ext_vector_type(4)));
typedef unsigned u32x4 __attribute__((ext_vector_type(4)));
constexpr int BM = 256, BK = 64, HALF = 128, HTB = HALF * BK * 2  , STAGE_BYTES = 8 * HTB, NXCD = 8, WGM = 8;

__host__ __device__ __forceinline__ int lds_byte(int r, int c) { const int st = (r >> 4) * 2 + (c >> 5), rr = r & 15, cc = c & 31, ob = rr * 64 + cc * 2; return st * 1024 + (ob ^ (((ob >> 9) & 1) << 5)); }
__host__ __device__ __forceinline__ void stage_rc(int b, int& R, int& C) { const int st = b / 1024, sb = b % 1024, swz = sb ^ (((sb >> 9) & 1) << 5); R = (st >> 1) * 16 + swz / 64; C = (st & 1) * 32 + (swz % 64) / 2; }
__host__ __device__ __forceinline__ int perm32(int rho) { const int n = rho >> 4, i = rho & 15; return 8 * (i >> 2) + 4 * n + (i & 3); }

struct Unit { int pm, pn; };
struct Gemm { const bf16_t* A; const bf16_t* Bt; int M, N, K; };

struct StaticOrder {
    int nM, nN, nwg, G, c;
    __host__ __device__ void init(int M, int N, int G_, int c_) { nM = M / BM; nN = N / BM; nwg = nM * nN; G = G_; c = c_; }
    __host__ __device__ __forceinline__ bool next(int i, Unit& u) const {
        const long L = (long)i * G + c; if (L >= nwg) return false;
        int wgid = (int)L; { const int q = nwg / NXCD, r = nwg % NXCD, xcd = wgid % NXCD, off = wgid / NXCD; wgid = (xcd < r ? xcd * (q + 1) : r * (q + 1) + (xcd - r) * q) + off; }
        const int nig = WGM * nN, gid = wgid / nig, fm = gid * WGM, gsz = (nM - fm) < WGM ? (nM - fm) : WGM;
        u.pm = fm + ((wgid % nig) % gsz); u.pn = (wgid % nig) / gsz; return true;
    }
    __device__ __forceinline__ void a_ready(const Unit&) const {}
    __device__ __forceinline__ void done(const Unit&) const {}
};

__device__ __forceinline__ unsigned cvt_pk_bf16(float lo, float hi) { unsigned r; asm volatile("v_cvt_pk_bf16_f32 %0, %1, %2" : "=v"(r) : "v"(lo), "v"(hi)); return r; }
struct AMapPlain {
    __device__ static __forceinline__ int lda(const Gemm& g) { return g.K; }
    __device__ static __forceinline__ size_t kstep(const Gemm&) { return (size_t)(BK * 2); }
    __device__ static __forceinline__ size_t hstep(const Gemm& g) { return (size_t)HALF * g.K * 2; }
    __device__ static __forceinline__ const char* base(const Gemm& g, int pm) { return (const char*)g.A + (size_t)pm * 2 * HALF * g.K * 2; }
};
struct AMapCmp {
    __device__ static __forceinline__ int lda(const Gemm&) { return 16 * ZP; }
    __device__ static __forceinline__ size_t kstep(const Gemm&) { return (size_t)ZP * 2; }
    __device__ static __forceinline__ size_t hstep(const Gemm&) { return (size_t)128; }
    __device__ static __forceinline__ const char* base(const Gemm& g, int pm) { return (const char*)g.A + ((size_t)(pm >> 1) * SEQ * ZP + (size_t)(pm & 1) * 128) * 2; }
};

__device__ __forceinline__ float gelu_tanh(float v) {
    const float e = __builtin_amdgcn_exp2f(-2.302208198f * v * (1.0f + 0.044715f * v * v));
    return v * __builtin_amdgcn_rcpf(1.0f + e);
}
template <int ACT> struct EpiAct {
    static constexpr bool PERM = true, AFTER_DRAIN = false, HAS_MID = false;
    bf16_t* O; int ldc; const float* bias; const float* rowscale;
    __device__ __forceinline__ void operator()(const f32x4 (&acc)[2][2][4][2], const Unit& u, int wr, int wc, int fr, int fq) const {
        const int row0 = u.pm * BM + wr * 64 + fr; const int col0 = u.pn * BM + wc * 32 + 8 * fq;
        f32x4 bv[2][2];
#pragma unroll
        for (int bj = 0; bj < 2; ++bj)
#pragma unroll
            for (int n = 0; n < 2; ++n) bv[bj][n] = bias ? *(const f32x4*)(bias + col0 + bj * HALF + 4 * n) : (f32x4){0.f, 0.f, 0.f, 0.f};
#pragma unroll
        for (int ai = 0; ai < 2; ++ai)
#pragma unroll
            for (int m = 0; m < 4; ++m) { bf16_t* rowp = O + (size_t)(row0 + ai * HALF + m * 16) * ldc + col0; const float rsc = rowscale ? rowscale[row0 + ai * HALF + m * 16] : 1.0f;
#pragma unroll
                for (int bj = 0; bj < 2; ++bj) { f32x4 v0 = acc[ai][bj][m][0] * rsc + bv[bj][0], v1 = acc[ai][bj][m][1] * rsc + bv[bj][1];
                    if (ACT == 2) {
#pragma unroll
                        for (int e = 0; e < 4; ++e) { v0[e] = gelu_tanh(v0[e]); v1[e] = gelu_tanh(v1[e]); } }
                    if (ACT == 3) {
#pragma unroll
                        for (int e = 0; e < 4; ++e) { const float a = fmaxf(v0[e], 0.f), b = fmaxf(v1[e], 0.f); v0[e] = a * a; v1[e] = b * b; } }
                    u32x4 w; w.x = cvt_pk_bf16(v0[0], v0[1]); w.y = cvt_pk_bf16(v0[2], v0[3]); w.z = cvt_pk_bf16(v1[0], v1[1]); w.w = cvt_pk_bf16(v1[2], v1[3]);
                    *(u32x4*)(rowp + bj * HALF) = w; } }
    }
};
struct EpiSsq {
    static constexpr bool PERM = true, AFTER_DRAIN = false, HAS_MID = false;
    bf16_t* O; int ldc; float* ssq;
    __device__ __forceinline__ void operator()(const f32x4 (&acc)[2][2][4][2], const Unit& u, int wr, int wc, int fr, int fq) const {
        const int row0 = u.pm * BM + wr * 64 + fr; const int col0 = u.pn * BM + wc * 32 + 8 * fq;
#pragma unroll
        for (int ai = 0; ai < 2; ++ai)
#pragma unroll
            for (int m = 0; m < 4; ++m) { const int row = row0 + ai * HALF + m * 16; bf16_t* rowp = O + (size_t)row * ldc + col0; float s = 0.f;
#pragma unroll
                for (int bj = 0; bj < 2; ++bj) { const f32x4 v0 = acc[ai][bj][m][0], v1 = acc[ai][bj][m][1];
                    s += (v0[0] * v0[0] + v0[1] * v0[1]) + (v0[2] * v0[2] + v0[3] * v0[3]); s += (v1[0] * v1[0] + v1[1] * v1[1]) + (v1[2] * v1[2] + v1[3] * v1[3]);
                    u32x4 w; w.x = cvt_pk_bf16(v0[0], v0[1]); w.y = cvt_pk_bf16(v0[2], v0[3]); w.z = cvt_pk_bf16(v1[0], v1[1]); w.w = cvt_pk_bf16(v1[2], v1[3]);
                    *(u32x4*)(rowp + bj * HALF) = w; }
                s += __shfl_xor(s, 16); s += __shfl_xor(s, 32);
                if (fq == 0) ssq[(size_t)row * 32 + u.pn * 4 + wc] = s; }
    }
};
struct EpiGate {
    static constexpr bool PERM = true, AFTER_DRAIN = false, HAS_MID = false;
    float* out; const bf16_t* h2; const bf16_t* pp; int ldc;
    __device__ __forceinline__ void operator()(const f32x4 (&acc)[2][2][4][2], const Unit& u, int wr, int wc, int fr, int fq) const {
        const int row0 = u.pm * BM + wr * 64 + fr; const int col0 = u.pn * BM + wc * 32 + 8 * fq;
#pragma unroll
        for (int ai = 0; ai < 2; ++ai)
#pragma unroll
            for (int m = 0; m < 4; ++m) { const size_t ro = (size_t)(row0 + ai * HALF + m * 16) * ldc + col0;
#pragma unroll
                for (int bj = 0; bj < 2; ++bj) { const f32x4 v0 = acc[ai][bj][m][0], v1 = acc[ai][bj][m][1];
                    const u32x4 pw = *(const u32x4*)(pp + ro + bj * HALF), hw = *(const u32x4*)(h2 + ro + bj * HALF); float* op = out + ro + bj * HALF;
                    const unsigned pu[4] = {pw.x, pw.y, pw.z, pw.w}, hu[4] = {hw.x, hw.y, hw.z, hw.w};
                    f32x4 h0, h1;
#pragma unroll
                    for (int e = 0; e < 4; ++e) { h0[e] = __uint_as_float((e & 1) ? (hu[e >> 1] & 0xffff0000u) : (hu[e >> 1] << 16)); h1[e] = __uint_as_float((e & 1) ? (hu[2 + (e >> 1)] & 0xffff0000u) : (hu[2 + (e >> 1)] << 16)); }
#pragma unroll
                    for (int e = 0; e < 4; ++e) { const float p0 = __uint_as_float((e & 1) ? (pu[e >> 1] & 0xffff0000u) : (pu[e >> 1] << 16));
                        const float p1 = __uint_as_float((e & 1) ? (pu[2 + (e >> 1)] & 0xffff0000u) : (pu[2 + (e >> 1)] << 16));
                        h0[e] += __builtin_amdgcn_rcpf(1.0f + __builtin_amdgcn_exp2f(-LOG2E * v0[e])) * p0;
                        h1[e] += __builtin_amdgcn_rcpf(1.0f + __builtin_amdgcn_exp2f(-LOG2E * v1[e])) * p1; }
                    *(f32x4*)op = h0; *(f32x4*)(op + 4) = h1; } }
    }
};
struct EpiSsqY {
    static constexpr bool PERM = true, AFTER_DRAIN = false, HAS_MID = true;
    bf16_t* O; int ldc; float* ssq; const PG8_LAS float* tab;
    __device__ __forceinline__ void mid(f32x4 (&acc)[2][2][4][2], int ui, int wr, int fr) const {
#pragma unroll
        for (int ai = 0; ai < 2; ++ai)
#pragma unroll
            for (int m = 0; m < 4; ++m) { const float rt = tab[(ui * 256 + ai * HALF + wr * 64 + m * 16 + fr) * 2];
#pragma unroll
                for (int bj = 0; bj < 2; ++bj) { acc[ai][bj][m][0] *= rt; acc[ai][bj][m][1] *= rt; } }
    }
    __device__ __forceinline__ void fin(const f32x4 (&acc)[2][2][4][2], const Unit& u, int ui, int wr, int wc, int fr, int fq) const {
        const int row0 = u.pm * BM + wr * 64 + fr; const int col0 = u.pn * BM + wc * 32 + 8 * fq;
#pragma unroll
        for (int ai = 0; ai < 2; ++ai)
#pragma unroll
            for (int m = 0; m < 4; ++m) { const int row = row0 + ai * HALF + m * 16; bf16_t* rowp = O + (size_t)row * ldc + col0; float s = 0.f;
                const float rn = tab[(ui * 256 + ai * HALF + wr * 64 + m * 16 + fr) * 2 + 1];
#pragma unroll
                for (int bj = 0; bj < 2; ++bj) { const f32x4 v0 = acc[ai][bj][m][0] * rn, v1 = acc[ai][bj][m][1] * rn;
                    s += (v0[0] * v0[0] + v0[1] * v0[1]) + (v0[2] * v0[2] + v0[3] * v0[3]); s += (v1[0] * v1[0] + v1[1] * v1[1]) + (v1[2] * v1[2] + v1[3] * v1[3]);
                    u32x4 w; w.x = cvt_pk_bf16(v0[0], v0[1]); w.y = cvt_pk_bf16(v0[2], v0[3]); w.z = cvt_pk_bf16(v1[0], v1[1]); w.w = cvt_pk_bf16(v1[2], v1[3]);
                    *(u32x4*)(rowp + bj * HALF) = w; }
                s += __shfl_xor(s, 16); s += __shfl_xor(s, 32);
                if (fq == 0) ssq[(size_t)row * 32 + u.pn * 4 + wc] = s; }
    }
};
template <class Epi, class Sched, class AM, bool ALIGN_EPI = false, bool SP2 = false>
__device__ __forceinline__ void gemm_phase(PG8_LAS unsigned char* lds, const Gemm g, const Sched& S, const Epi& E) {
    const int tid = threadIdx.x, wid = __builtin_amdgcn_readfirstlane(tid >> 6), lane = tid & 63, wr = wid >> 2, wc = wid & 3, fr = lane & 15, fq = lane >> 4;
    const int K = g.K, nt = K / BK;
    unsigned voffA[2], voffB[2];
#pragma unroll
    for (int i = 0; i < 2; ++i) { int R, C; stage_rc(tid * 16 + i * 8192, R, C); const int Rb = Epi::PERM ? ((R & ~31) + perm32(R & 31)) : R;
        voffA[i] = (unsigned)(R * AM::lda(g) + C) * 2u; voffB[i] = (unsigned)(Rb * K + C) * 2u; }
    const size_t kstep = (size_t)(BK * 2); const size_t kstepA = AM::kstep(g), hstepA = AM::hstep(g);
    const size_t hstep = (size_t)HALF * K * 2;
    const size_t tstep = 2 * hstep;
    const unsigned ldsw = (unsigned)wid * 1024u;
    const int aoff = lds_byte(wr * 64 + fr, fq * 8), boff = lds_byte(wc * 32 + fr, fq * 8);
#define PG8_SA(b, h) (((b) * 2 + (h)) * HTB)
#define PG8_SB(b, h) ((4 + (b) * 2 + (h)) * HTB)
#define PG8_STAGE(bufoff, gbase, voff) do { _Pragma("unroll") for (int _i = 0; _i < 2; ++_i) \
        __builtin_amdgcn_global_load_lds((const unsigned*)((const char*)(gbase) + (voff)[_i]), (PG8_LAS unsigned*)(lds + (bufoff) + ldsw + _i * 8192), 16, 0, 0); } while (0)
#define PG8_LDA(dst, b, h) do { _Pragma("unroll") for (int m = 0; m < 4; ++m) _Pragma("unroll") for (int k = 0; k < 2; ++k) dst[m][k] = *(const PG8_LAS bf16x8*)(lds + PG8_SA(b, h) + aoff + m * 2048 + k * 1024); } while (0)
#define PG8_LDB(dst, b, h) do { _Pragma("unroll") for (int n = 0; n < 2; ++n) _Pragma("unroll") for (int k = 0; k < 2; ++k) dst[n][k] = *(const PG8_LAS bf16x8*)(lds + PG8_SB(b, h) + boff + n * 2048 + k * 1024); } while (0)
#define PG8_MMA(ai, bj, At, Bt) do { __builtin_amdgcn_s_setprio(1); _Pragma("unroll") for (int m = 0; m < 4; ++m) _Pragma("unroll") for (int n = 0; n < 2; ++n) _Pragma("unroll") for (int k = 0; k < 2; ++k) \
        acc[ai][bj][m][n] = __builtin_amdgcn_mfma_f32_16x16x32_bf16(Bt[n][k], At[m][k], acc[ai][bj][m][n], 0, 0, 0); __builtin_amdgcn_s_setprio(0); } while (0)
#define PG8_WAIT_V(n) asm volatile("s_waitcnt vmcnt(" #n ")" ::: "memory")
#define PG8_WAIT_L(n) asm volatile("s_waitcnt lgkmcnt(" #n ")" ::: "memory")
#define PG8_BAR __builtin_amdgcn_s_barrier()
#define PG8_SCHED __builtin_amdgcn_sched_barrier(0)
    Unit cur, nxt; int ui = 0;
    if (!S.next(0, cur)) return;
    f32x4 acc[2][2][4][2];
#pragma unroll
    for (int a = 0; a < 2; ++a)
#pragma unroll
        for (int b = 0; b < 2; ++b)
#pragma unroll
            for (int m = 0; m < 4; ++m)
#pragma unroll
                for (int n = 0; n < 2; ++n) acc[a][b][m][n] = (f32x4){0.f, 0.f, 0.f, 0.f};
    bf16x8 At[4][2], B0[2][2], B1[2][2];
    const char* cA = AM::base(g, cur.pm); const char* cB = (const char*)g.Bt + (size_t)cur.pn * tstep;
    S.a_ready(cur);
    if constexpr (SP2) {
        PG8_STAGE(PG8_SB(0, 0), cB, voffB); PG8_STAGE(PG8_SB(0, 1), cB + hstep, voffB); PG8_STAGE(PG8_SA(0, 0), cA, voffA); PG8_STAGE(PG8_SA(0, 1), cA + hstepA, voffA);
        if (wr == 1) PG8_BAR;
        PG8_WAIT_V(2); PG8_BAR;
        PG8_STAGE(PG8_SB(1, 0), cB + kstep, voffB); PG8_STAGE(PG8_SA(1, 0), cA + kstepA, voffA); PG8_STAGE(PG8_SB(1, 1), cB + hstep + kstep, voffB);
        PG8_WAIT_V(6); PG8_BAR;
    } else {
        PG8_STAGE(PG8_SB(0, 0), cB, voffB); PG8_STAGE(PG8_SA(0, 0), cA, voffA); PG8_STAGE(PG8_SB(0, 1), cB + hstep, voffB); PG8_STAGE(PG8_SA(0, 1), cA + hstepA, voffA);
        if (wr == 1) PG8_BAR;
        PG8_WAIT_V(4); PG8_BAR;
        PG8_STAGE(PG8_SB(1, 0), cB + kstep, voffB); PG8_STAGE(PG8_SA(1, 0), cA + kstepA, voffA); PG8_STAGE(PG8_SB(1, 1), cB + hstep + kstep, voffB);
        PG8_WAIT_V(6); PG8_BAR;
    }
    for (;;) {
        const bool has_next = S.next(ui + 1, nxt);
        const char* nA = has_next ? AM::base(g, nxt.pm) : cA; const char* nB = has_next ? (const char*)g.Bt + (size_t)nxt.pn * tstep : cB;
        for (int t = 0; t < nt; t += 2) {
            const bool last = (t == nt - 2);
            const char* a1 = cA + (size_t)(t + 1) * kstepA;
            const char* a2 = last ? nA : cA + (size_t)(t + 2) * kstepA; const char* b2 = last ? nB : cB + (size_t)(t + 2) * kstep;
            const char* a3 = a2 + kstepA; const char* b3 = b2 + kstep;
            if (last && has_next) S.a_ready(nxt);
            if constexpr (Epi::HAS_MID) { if (t == nt / 2) E.mid(acc, ui, wr, fr); }
            if constexpr (SP2) {
            PG8_LDB(B0, 0, 0); PG8_LDB(B1, 0, 1); PG8_SCHED; PG8_LDA(At, 0, 0); PG8_STAGE(PG8_SA(1, 1), a1 + hstepA, voffA);
            PG8_WAIT_V(8); PG8_WAIT_L(0); PG8_BAR; PG8_MMA(0, 0, At, B0); PG8_MMA(0, 1, At, B1); PG8_BAR; PG8_SCHED;
            PG8_LDA(At, 0, 1); PG8_STAGE(PG8_SB(0, 0), b2, voffB); PG8_STAGE(PG8_SB(0, 1), b2 + hstep, voffB); PG8_STAGE(PG8_SA(0, 0), a2, voffA);
            PG8_WAIT_V(8); PG8_WAIT_L(0); PG8_BAR; PG8_MMA(1, 0, At, B0); PG8_MMA(1, 1, At, B1); PG8_BAR; PG8_SCHED;
            PG8_LDB(B0, 1, 0); PG8_LDB(B1, 1, 1); PG8_SCHED; PG8_LDA(At, 1, 0); PG8_STAGE(PG8_SA(0, 1), a2 + hstepA, voffA);
            PG8_WAIT_V(8); PG8_WAIT_L(0); PG8_BAR; PG8_MMA(0, 0, At, B0); PG8_MMA(0, 1, At, B1); PG8_BAR; PG8_SCHED;
            PG8_LDA(At, 1, 1); PG8_STAGE(PG8_SB(1, 0), b3, voffB); PG8_STAGE(PG8_SB(1, 1), b3 + hstep, voffB); PG8_STAGE(PG8_SA(1, 0), a3, voffA);
            PG8_WAIT_V(8); PG8_WAIT_L(0); PG8_BAR; PG8_MMA(1, 0, At, B0); PG8_MMA(1, 1, At, B1); PG8_BAR; PG8_SCHED;
            } else {
            PG8_LDB(B0, 0, 0); PG8_SCHED; PG8_LDA(At, 0, 0); PG8_STAGE(PG8_SA(1, 1), a1 + hstepA, voffA);
            PG8_WAIT_L(8); PG8_BAR; PG8_WAIT_L(0); PG8_MMA(0, 0, At, B0); PG8_BAR; PG8_SCHED;
            PG8_LDB(B1, 0, 1); PG8_STAGE(PG8_SB(0, 0), b2, voffB);
            PG8_BAR; PG8_WAIT_L(0); PG8_MMA(0, 1, At, B1); PG8_BAR;
            PG8_LDA(At, 0, 1); PG8_STAGE(PG8_SA(0, 0), a2, voffA);
            PG8_BAR; PG8_WAIT_L(0); PG8_MMA(1, 0, At, B0); PG8_BAR; PG8_SCHED;
            PG8_STAGE(PG8_SB(0, 1), b2 + hstep, voffB);
            PG8_WAIT_V(6); PG8_BAR; PG8_MMA(1, 1, At, B1); PG8_BAR;
            PG8_LDB(B0, 1, 0); PG8_SCHED; PG8_LDA(At, 1, 0); PG8_STAGE(PG8_SA(0, 1), a2 + hstepA, voffA);
            PG8_WAIT_L(8); PG8_BAR; PG8_WAIT_L(0); PG8_MMA(0, 0, At, B0); PG8_BAR; PG8_SCHED;
            PG8_LDB(B1, 1, 1); PG8_STAGE(PG8_SB(1, 0), b3, voffB);
            PG8_BAR; PG8_WAIT_L(0); PG8_MMA(0, 1, At, B1); PG8_BAR;
            PG8_LDA(At, 1, 1); PG8_STAGE(PG8_SA(1, 0), a3, voffA);
            PG8_BAR; PG8_WAIT_L(0); PG8_MMA(1, 0, At, B0); PG8_BAR; PG8_SCHED;
            PG8_STAGE(PG8_SB(1, 1), b3 + hstep, voffB);
            PG8_WAIT_V(6); PG8_BAR; PG8_MMA(1, 1, At, B1); PG8_BAR;
            }
        }
        if constexpr (ALIGN_EPI) { if (wr == 0) PG8_BAR; }
        if constexpr (!Epi::AFTER_DRAIN) { if constexpr (Epi::HAS_MID) E.fin(acc, cur, ui, wr, wc, fr, fq); else E(acc, cur, wr, wc, fr, fq); S.done(cur); }
        if (!has_next) break;
#pragma unroll
        for (int a = 0; a < 2; ++a)
#pragma unroll
            for (int b = 0; b < 2; ++b)
#pragma unroll
                for (int m = 0; m < 4; ++m)
#pragma unroll
                    for (int n = 0; n < 2; ++n) acc[a][b][m][n] = (f32x4){0.f, 0.f, 0.f, 0.f};
        cur = nxt; cA = nA; cB = nB; ++ui;
        if constexpr (ALIGN_EPI) { if (wr == 1) PG8_BAR; }
    }
    PG8_WAIT_V(0);
    if constexpr (!ALIGN_EPI) { if (wr == 0) PG8_BAR; }
    PG8_BAR;
    if constexpr (Epi::AFTER_DRAIN) { E.fused(acc, cur, wr, wc, fr, fq, lds, wid, lane); S.done(cur); }
#undef PG8_SA
#undef PG8_SB
#undef PG8_STAGE
#undef PG8_LDA
#undef PG8_LDB
#undef PG8_MMA
#undef PG8_WAIT_V
#undef PG8_WAIT_L
#undef PG8_BAR
#undef PG8_SCHED
}
}
constexpr size_t MiB = 1u << 20;
constexpr size_t WS_CTL = 0, CTL_ZERO_BYTES = 1 * MiB;
constexpr size_t WS_WIN = 2 * MiB, WS_WOUT = 21 * MiB, WS_W1 = 29 * MiB, WS_W2 = 61 * MiB, WS_WG = 93 * MiB, WS_WP = 101 * MiB, WS_CW1K = 102 * MiB, WS_CW1V = 103 * MiB;
constexpr size_t WS_MISC = 104 * MiB;
constexpr size_t WS_PB = 105 * MiB;
constexpr size_t WS_HID = 121 * MiB;
constexpr size_t WS_KCVC = 129 * MiB;
constexpr size_t WS_SSL = 131 * MiB, WS_SSN = 133 * MiB;
constexpr size_t WS_SSQ = 134 * MiB;
constexpr size_t WS_A = 140 * MiB;
constexpr size_t WS_Z = 268 * MiB;
constexpr size_t WS_Y = 573 * MiB;
constexpr size_t WS_T = 701 * MiB;
constexpr size_t WS_HID2 = 268 * MiB;
constexpr size_t WS_F = 780 * MiB;
constexpr size_t WS_PP = 268 * MiB;
constexpr size_t WS_END = 908 * MiB;
constexpr int CW_TMO = 0, CW_CODE = 1, CW_BAR = 4096;

constexpr int RING_OFF = 0, RING_BYTES = 131072;
constexpr int LDSCTL_OFF = RING_BYTES, MISC_OFF = LDSCTL_OFF + 320;
constexpr int LDS_BYTES = 147456;
constexpr int NWAVES = 8;

#define GAS __attribute__((address_space(1)))
#define LAS __attribute__((address_space(3)))
typedef unsigned short bf16;
typedef unsigned v4u __attribute__((ext_vector_type(4)));
typedef unsigned v2u __attribute__((ext_vector_type(2)));
typedef float f32x4 __attribute__((ext_vector_type(4)));
typedef float f32x16 __attribute__((ext_vector_type(16)));
typedef short bf16x8 __attribute__((ext_vector_type(8)));
typedef short s16x4 __attribute__((ext_vector_type(4)));
typedef GAS unsigned gu32;
#define RLX_AGENT __ATOMIC_RELAXED, __HIP_MEMORY_SCOPE_AGENT
#define LDS_WAIT() asm volatile("s_waitcnt lgkmcnt(0)" ::: "memory")
#define VM_WAIT() asm volatile("s_waitcnt vmcnt(0)" ::: "memory")
__device__ __forceinline__ unsigned f2bf(float f) { unsigned u = __builtin_bit_cast(unsigned, f); return (u + 0x7fffu + ((u >> 16) & 1u)) >> 16; }
__device__ __forceinline__ unsigned pk2(float lo, float hi) { return f2bf(lo) | (f2bf(hi) << 16); }
__device__ __forceinline__ float bf2f(unsigned b) { return __uint_as_float(b << 16); }
__device__ __forceinline__ float bflo(unsigned w) { return __uint_as_float(w << 16); }
__device__ __forceinline__ float bfhi(unsigned w) { return __uint_as_float(w & 0xffff0000u); }
__device__ __forceinline__ float wave_sum(float v) {
#pragma unroll
    for (int o = 1; o < 64; o <<= 1) v += __shfl_xor(v, o);
    return v;
}
__device__ __forceinline__ float sigmoidf_(float v) { return __builtin_amdgcn_rcpf(1.0f + __builtin_amdgcn_exp2f(-LOG2E * v)); }
#define XB_TMO      128
#define XB_XCNT(j)  (256  + 64 * (j))
#define XB_XSUB(j)  (1280 + 64 * (j))
#define XB_XGEN(j)  (2304 + 64 * (j))
#define XB_TOP      3328
#define XB_TOPGEN   3392
#define XCD_BAR_WORDS 3456
#define XB_SPIN_CAP (1u << 18)

__device__ __forceinline__ unsigned xb_ld(unsigned* p)              { return __hip_atomic_load(p, __ATOMIC_RELAXED, __HIP_MEMORY_SCOPE_AGENT); }
__device__ __forceinline__ unsigned xb_add(unsigned* p, unsigned v) { return __hip_atomic_fetch_add(p, v, __ATOMIC_RELAXED, __HIP_MEMORY_SCOPE_AGENT); }
__device__ __forceinline__ unsigned xb_xcc_id() { return (unsigned)__builtin_amdgcn_s_getreg((3 << 11) | 20) & 0xFu; }
#define XB_SPIN(cond, bar) do { unsigned _sp = 0; while (cond) { __builtin_amdgcn_s_sleep(1); \
    if ((++_sp & 255u) == 0u) { if (xb_ld(&(bar)[XB_TMO])) break; if (_sp > XB_SPIN_CAP) { atomicAdd(&(bar)[XB_TMO], 1u); break; } } } } while (0)

struct XcdBarrier {
    unsigned* bar; unsigned x;
    volatile LAS unsigned* st;
};

__device__ __forceinline__ XcdBarrier xcd_barrier_post(unsigned* bar, volatile LAS unsigned* st) {
    XcdBarrier b; b.bar = bar; b.x = xb_xcc_id(); b.st = st;
    if (threadIdx.x == 0) (void)xb_add(&bar[XB_XCNT(b.x)], 1u);
    return b;
}
__device__ __forceinline__ void xcd_barrier_complete(unsigned* bar, unsigned x, unsigned& nloc, unsigned& nx) {
    const unsigned G = gridDim.x * gridDim.y * gridDim.z;
    unsigned sum, cnt, mine, sp = 0u;
    for (;;) {
        sum = 0u; cnt = 0u; mine = 0u;
#pragma unroll
        for (unsigned j = 0; j < 16; ++j) { const unsigned c = xb_ld(&bar[XB_XCNT(j)]); sum += c; cnt += (c > 0u) ? 1u : 0u; mine = (j == x) ? c : mine; }
        if (sum == G) break;
        __builtin_amdgcn_s_sleep(1);
        if ((++sp & 255u) == 0u) { if (xb_ld(&bar[XB_TMO])) break; if (sp > XB_SPIN_CAP) { atomicAdd(&bar[XB_TMO], 1u); break; } }
    }
    nloc = mine > 0u ? mine : 1u; nx = cnt > 0u ? cnt : 1u;
}

__device__ __forceinline__ void xcd_barrier(const XcdBarrier& b) {
    asm volatile("s_waitcnt vmcnt(0)" ::: "memory");
    __syncthreads();
    if (threadIdx.x == 0) {
        unsigned* bar = b.bar;
        __builtin_amdgcn_s_waitcnt(0);
        unsigned nloc = b.st[0], nx = b.st[1];
        if (nloc == 0u) { xcd_barrier_complete(bar, b.x, nloc, nx); b.st[0] = nloc; b.st[1] = nx; }
        const unsigned old = xb_add(&bar[XB_XSUB(b.x)], 1u);
        const unsigned gen = old / nloc;
        if (old + 1u == (gen + 1u) * nloc) {
            __builtin_amdgcn_fence(__ATOMIC_RELEASE, "agent");
            asm volatile("s_waitcnt vmcnt(0)" ::: "memory");
            const unsigned og = xb_add(&bar[XB_TOP], 1u);
            const unsigned tg = og / nx;
            if (og + 1u == (tg + 1u) * nx) xb_add(&bar[XB_TOPGEN], 1u);
            else XB_SPIN(xb_ld(&bar[XB_TOPGEN]) == tg, bar);
            __builtin_amdgcn_fence(__ATOMIC_ACQUIRE, "agent");
            xb_add(&bar[XB_XGEN(b.x)], 1u);
            asm volatile("s_waitcnt vmcnt(0)" ::: "memory");
        } else {
            XB_SPIN(xb_ld(&bar[XB_XGEN(b.x)]) == gen, bar);
            __builtin_amdgcn_fence(__ATOMIC_ACQUIRE, "agent");
            asm volatile("s_waitcnt vmcnt(0)" ::: "memory");
        }
    }
    __syncthreads();
}

namespace nsa {
constexpr int KPB = 144, VPB = 160;
constexpr int KBUF = 64 * KPB, VBUF = 64 * VPB;
constexpr int NBUF = 3, L_K = 0, L_V = NBUF * KBUF, L_BIAS = L_V + NBUF * VBUF, L_PSUM = L_BIAS + 2048, L_IMPV = L_PSUM + 128 * 65 * 4, L_SEL = L_IMPV + 64 * 32 * 4, L_STASH = L_PSUM  , L_SSQ = L_STASH + 65536, L_END = L_SSQ + 1024;
static_assert(L_SEL + 256 <= L_SSQ, "nsa LDS overlay");
static_assert(L_END <= RING_BYTES, "nsa LDS");
constexpr float NEG = -1.0e30f;
constexpr float C1 = 0.125f * LOG2E;
__device__ __forceinline__ int crow(int i, int hh) { return (i & 3) + 8 * (i >> 2) + 4 * hh; }
__device__ __forceinline__ int t5_bucket(int n) {
    if (n < 16) return n;
    int b = 16;
    b += (n >= 19); b += (n >= 21); b += (n >= 24); b += (n >= 27); b += (n >= 31); b += (n >= 35); b += (n >= 40); b += (n >= 46);
    b += (n >= 52); b += (n >= 59); b += (n >= 67); b += (n >= 77); b += (n >= 87); b += (n >= 99); b += (n >= 113);
    return b;
}
__device__ __forceinline__ s16x4 trr(const LAS char* p) { return __builtin_bit_cast(s16x4, __builtin_amdgcn_ds_read_tr16_b64_v4i16((LAS s16x4*)p)); }
__device__ __forceinline__ unsigned cvtpk(float lo, float hi) { typedef float f2 __attribute__((ext_vector_type(2))); typedef __bf16 b2 __attribute__((ext_vector_type(2))); f2 v = {lo, hi}; b2 r = __builtin_convertvector(v, b2); return __builtin_bit_cast(unsigned, r); }
#define NSA_MFMA(a, b, c) __builtin_amdgcn_mfma_f32_32x32x16_bf16((a), (b), (c), 0, 0, 0)

__device__ __forceinline__ void qk_tile(f32x16& s0, f32x16& s1, const LAS char* kbuf, const bf16x8 (&qf)[4], int r32, int hh) {
    const LAS char* kb = kbuf + r32 * KPB + hh * 16;
    const f32x16 z = {0.f,0.f,0.f,0.f,0.f,0.f,0.f,0.f,0.f,0.f,0.f,0.f,0.f,0.f,0.f,0.f};
    { const bf16x8 a0 = *(const LAS bf16x8*)(kb), a1 = *(const LAS bf16x8*)(kb + 32 * KPB);
      s0 = NSA_MFMA(a0, qf[0], z); s1 = NSA_MFMA(a1, qf[0], z); }
#pragma unroll
    for (int d0 = 1; d0 < 4; ++d0) {
        const bf16x8 a0 = *(const LAS bf16x8*)(kb + d0 * 32), a1 = *(const LAS bf16x8*)(kb + 32 * KPB + d0 * 32);
        s0 = NSA_MFMA(a0, qf[d0], s0); s1 = NSA_MFMA(a1, qf[d0], s1);
    }
}
__device__ __forceinline__ void pv_tile(f32x16 (&o)[2], const LAS char* vbuf, const f32x16& p0, const f32x16& p1, int lane) {
    const int hh = lane >> 5, q4 = (lane & 15) >> 2, pp = lane & 3, blk = (lane >> 4) & 1;
    const LAS char* vb = vbuf + (4 * hh + q4) * VPB + blk * 32 + pp * 8;
#define NSA_PK(P, B) ({ v4u w_; w_.x = cvtpk(P[B], P[B + 1]); w_.y = cvtpk(P[B + 2], P[B + 3]); w_.z = cvtpk(P[B + 4], P[B + 5]); w_.w = cvtpk(P[B + 6], P[B + 7]); __builtin_bit_cast(bf16x8, w_); })
#pragma unroll
    for (int s = 0; s < 4; ++s) {
        const bf16x8 pf = (s == 0) ? NSA_PK(p0, 0) : (s == 1) ? NSA_PK(p0, 8) : (s == 2) ? NSA_PK(p1, 0) : NSA_PK(p1, 8);
#pragma unroll
        for (int db = 0; db < 2; ++db) {
            const s16x4 lo = trr(vb + (16 * s) * VPB + db * 64), hi = trr(vb + (16 * s + 8) * VPB + db * 64);
            const bf16x8 vf = {lo[0], lo[1], lo[2], lo[3], hi[0], hi[1], hi[2], hi[3]};
            o[db] = NSA_MFMA(vf, pf, o[db]);
        }
        __builtin_amdgcn_sched_barrier(0);
    }
#undef NSA_PK
}
template <int KS> __device__ __forceinline__ void gen_fix(f32x16& s0, f32x16& s1, int dq, int hi_excl, bool rowok, float off, const LAS float* biasr, int hh) {
    const int dbase = dq - 4 * hh * KS;
    { float bb[16];
#pragma unroll
      for (int i = 0; i < 16; ++i) { const int d0 = dbase - ((i & 3) + 8 * (i >> 2)) * KS; bb[i] = biasr[min(max(d0, 0), 127)]; }
      __builtin_amdgcn_sched_barrier(0);
#pragma unroll
      for (int i = 0; i < 16; ++i) { const int d0 = dbase - ((i & 3) + 8 * (i >> 2)) * KS; const bool v0 = rowok && d0 >= 0 && d0 < hi_excl; s0[i] = v0 ? s0[i] + (bb[i] + off) : NEG; } }
    __builtin_amdgcn_sched_barrier(0);
    { float bb[16];
#pragma unroll
      for (int i = 0; i < 16; ++i) { const int d1 = dbase - ((i & 3) + 8 * (i >> 2) + 32) * KS; bb[i] = biasr[min(max(d1, 0), 127)]; }
      __builtin_amdgcn_sched_barrier(0);
#pragma unroll
      for (int i = 0; i < 16; ++i) { const int d1 = dbase - ((i & 3) + 8 * (i >> 2) + 32) * KS; const bool v1 = rowok && d1 >= 0 && d1 < hi_excl; s1[i] = v1 ? s1[i] + (bb[i] + off) : NEG; } }
}
__device__ __forceinline__ float max3f(float a, float b, float c) { float r; asm("v_max3_f32 %0, %1, %2, %3" : "=v"(r) : "v"(a), "v"(b), "v"(c)); return r; }
__device__ __forceinline__ float max32(const f32x16& a, const f32x16& b) {
    float x = max3f(a[0], a[1], a[2]), y = max3f(b[0], b[1], b[2]);
    x = max3f(x, a[3], a[4]); y = max3f(y, b[3], b[4]); x = max3f(x, a[5], a[6]); y = max3f(y, b[5], b[6]);
    x = max3f(x, a[7], a[8]); y = max3f(y, b[7], b[8]); x = max3f(x, a[9], a[10]); y = max3f(y, b[9], b[10]);
    x = max3f(x, a[11], a[12]); y = max3f(y, b[11], b[12]); x = max3f(x, a[13], a[14]); y = max3f(y, b[13], b[14]);
    return max3f(x, y, fmaxf(a[15], b[15]));
}
template <int KS, bool GEN> __device__ __forceinline__ void tile_soft(f32x16& s0, f32x16& s1, const LAS char* vbuf, float& negm, f32x16 (&o)[2], float& lacc,
                                                                       bool first, bool rowok, float bfar, int dq, int hi_excl, const LAS float* biasr, int lane);
template <int KS, bool GEN> __device__ __forceinline__ void tile_step(const LAS char* kbuf, const LAS char* vbuf, const bf16x8 (&qf)[4], float& negm, f32x16 (&o)[2], float& lacc,
                                                                       bool first, bool rowok, float bfar, int dq, int hi_excl, const LAS float* biasr, int lane) {
    const int r32 = lane & 31, hh = lane >> 5;
    f32x16 s0, s1;
    qk_tile(s0, s1, kbuf, qf, r32, hh);
    tile_soft<KS, GEN>(s0, s1, vbuf, negm, o, lacc, first, rowok, bfar, dq, hi_excl, biasr, lane);
}
template <int KS, bool GEN> __device__ __forceinline__ void tile_soft(f32x16& s0, f32x16& s1, const LAS char* vbuf, float& negm, f32x16 (&o)[2], float& lacc,
                                                                       bool first, bool rowok, float bfar, int dq, int hi_excl, const LAS float* biasr, int lane) {
    const int hh = lane >> 5;
    constexpr float THR = 8.0f;
    float cv = rowok ? bfar + negm : NEG;
    if (GEN) { gen_fix<KS>(s0, s1, dq, hi_excl, rowok, negm, biasr, hh); cv = 0.f; }
    float rm = max32(s0, s1) + cv; rm = fmaxf(rm, __shfl_xor(rm, 32));
    const bool need = first ? (rm > -1.0e29f) : (rm > THR);
    if (__any(need)) {
        const float dl = need ? rm : 0.f, alpha = __builtin_amdgcn_exp2f(-dl);
        negm -= dl; cv -= dl;
#pragma unroll
        for (int i = 0; i < 16; ++i) { o[0][i] *= alpha; o[1][i] *= alpha; }
        lacc *= alpha;
    }
    float ps = 0.f;
#pragma unroll
    for (int i = 0; i < 16; ++i) { s0[i] = __builtin_amdgcn_exp2f(s0[i] + cv); s1[i] = __builtin_amdgcn_exp2f(s1[i] + cv); ps += s0[i] + s1[i]; }
    lacc += ps;
    pv_tile(o, vbuf, s0, s1, lane);
}

struct Tens { const bf16* z; const bf16* kcvc; const float* relb; bf16* y; float* ssn; };

__device__ __forceinline__ void branches(LAS char* lds, const Tens& T, int b, int g, int qt, int tq, const bf16x8 (&qf)[4], const LAS float* biasr, float bfar,
                                         unsigned selmask, float g_s, float g_w, LAS char* stash, int tid, int lane) {
    const int skey = tid >> 3, sch = tid & 7;
    const bf16* rowp = T.z + (size_t)(b * SEQ + skey) * ZP + g * 64 + sch * 8;
    const int n1 = qt + 1, lo2 = (qt > 8 ? qt - 8 : 0), total = n1 + (qt - lo2 + 1);
    LAS char* kdst = lds + L_K + skey * KPB + sch * 16; LAS char* vdst = lds + L_V + skey * VPB + sch * 16;
    float negm = 0.f, lacc = 0.f; f32x16 o[2];
#pragma unroll
    for (int i = 0; i < 16; ++i) { o[0][i] = 0.f; o[1][i] = 0.f; }
#define NSA_LOAD(j, kr, vr) do { int jl_ = (j); jl_ = jl_ < total ? jl_ : total - 1; const bool wl_ = jl_ >= n1; const int ktl_ = wl_ ? lo2 + (jl_ - n1) : jl_; \
        const bf16* pl_ = rowp + (size_t)ktl_ * 64 * ZP + (wl_ ? C_KW : C_KS); kr = *(const v4u*)pl_; vr = *(const v4u*)(pl_ + (C_VS - C_KS)); } while (0)
#define NSA_FLUSH(gate_) do { const float sc_ = (gate_) * __builtin_amdgcn_rcpf(lacc + __shfl_xor(lacc, 32)); \
        _Pragma("unroll") for (int db = 0; db < 2; ++db) _Pragma("unroll") for (int i4 = 0; i4 < 4; ++i4) { LAS f32x4* sp = (LAS f32x4*)(stash + (db * 4 + i4) * 1024); f32x4 y = *sp; \
            y.x = fmaf(sc_, o[db][4 * i4], y.x); y.y = fmaf(sc_, o[db][4 * i4 + 1], y.y); y.z = fmaf(sc_, o[db][4 * i4 + 2], y.z); y.w = fmaf(sc_, o[db][4 * i4 + 3], y.w); *sp = y; } } while (0)
#define NSA_BAR() asm volatile("s_waitcnt lgkmcnt(0)\n\ts_barrier" ::: "memory")
    static_assert(C_VS - C_KS == C_VW - C_KW, "K -> V column offset is the same for both branches");
    v4u kr, vr;
    NSA_LOAD(0, kr, vr); *(LAS v4u*)(kdst) = kr; *(LAS v4u*)(vdst) = vr;
    NSA_LOAD(1, kr, vr); *(LAS v4u*)(kdst + KBUF) = kr; *(LAS v4u*)(vdst + VBUF) = vr;
    NSA_BAR();
    int s_cur = 0, s_nxt = 1, s_fill = 2;
    const int r32 = lane & 31, hh = lane >> 5;
    f32x16 sa0, sa1, sb0, sb1;
    qk_tile(sa0, sa1, lds + L_K, qf, r32, hh);
#define NSA_STEP(j, C0, C1, N0, N1) do { const int j_ = (j); \
        if (j_ == n1) { NSA_FLUSH(g_s); negm = 0.f; lacc = 0.f; _Pragma("unroll") for (int i = 0; i < 16; ++i) { o[0][i] = 0.f; o[1][i] = 0.f; } } \
        NSA_LOAD(j_ + 2, kr, vr); \
        if (j_ + 1 < total) qk_tile(N0, N1, lds + L_K + s_nxt * KBUF, qf, r32, hh); \
        __builtin_amdgcn_sched_barrier(0); \
        const bool w_ = j_ >= n1; const int kt_ = w_ ? lo2 + (j_ - n1) : j_; \
        const bool first_ = (j_ == 0) || (j_ == n1); \
        const bool rowok_ = w_ ? true : (((selmask >> kt_) & 1u) != 0u); \
        const bool gen_ = (kt_ >= qt - 2) || (w_ && kt_ == qt - 8); \
        const int dq_ = tq - kt_ * 64; \
        if (gen_) tile_soft<1, true>(C0, C1, lds + L_V + s_cur * VBUF, negm, o, lacc, first_, rowok_, bfar, dq_, w_ ? 512 : 0x7fffffff, biasr, lane); \
        else tile_soft<1, false>(C0, C1, lds + L_V + s_cur * VBUF, negm, o, lacc, first_, rowok_, bfar, dq_, 0, biasr, lane); \
        *(LAS v4u*)(kdst + s_fill * KBUF) = kr; *(LAS v4u*)(vdst + s_fill * VBUF) = vr; \
        NSA_BAR(); \
        const int t_ = s_cur; s_cur = s_nxt; s_nxt = s_fill; s_fill = t_; } while (0)
#pragma unroll 1
    for (int j = 0; j < total; j += 2) {
        NSA_STEP(j, sa0, sa1, sb0, sb1);
        if (j + 1 < total) NSA_STEP(j + 1, sb0, sb1, sa0, sa1);
    }
#undef NSA_STEP
    NSA_FLUSH(g_w);
    __syncthreads();
#undef NSA_LOAD
#undef NSA_FLUSH
#undef NSA_BAR
}

__device__ __forceinline__ void fill_bias(LAS char* lds, const float* relb, int g) {
    int tid = threadIdx.x; asm volatile("" : "+v"(tid));
    const int rr = tid >> 7, d = tid & 127;
    ((LAS float*)(lds + L_BIAS))[tid] = relb[t5_bucket(d) * 16 + g * 4 + rr] * LOG2E;
}
#ifndef PROBE_MODE
#define PROBE_MODE 0
#endif
#define NSA_TSACC ((volatile LAS unsigned long long*)(LDSCTL_OFF + 1024 + 256))
#define NSA_MARK(k) do { if (PROBE_MODE && blockIdx.x == 0 && threadIdx.x == 0) { const unsigned long long t_ = __builtin_amdgcn_s_memrealtime(); NSA_TSACC[k] += t_ - NSA_TSACC[15]; NSA_TSACC[15] = t_; } } while (0)
__device__ __forceinline__ void unit(LAS char* lds, const Tens& T, int b, int g, int qt) {
    if (PROBE_MODE && blockIdx.x == 0 && threadIdx.x == 0) NSA_TSACC[15] = __builtin_amdgcn_s_memrealtime();
    int tid = threadIdx.x; asm volatile("" : "+v"(tid));
    const int lane = tid & 63, wid = __builtin_amdgcn_readfirstlane(tid >> 6);
    const int r = wid >> 1, qh = wid & 1, r32 = lane & 31, hh = lane >> 5;
    const int t0 = qt * 64, tq = t0 + qh * 32 + r32, head = g * 4 + r;
    const size_t zrow = (size_t)(b * SEQ + tq) * ZP;
    LAS float* BIAS = (LAS float*)(lds + L_BIAS);
    LAS float* IMPV = (LAS float*)(lds + L_IMPV);
    LAS unsigned* SEL = (LAS unsigned*)(lds + L_SEL);
    LAS float* SSQ = (LAS float*)(lds + L_SSQ);
    bf16x8 qf[4];
#pragma unroll
    for (int d0 = 0; d0 < 4; ++d0) { const v4u w = *(const v4u*)(T.z + zrow + C_Q + head * 64 + d0 * 16 + hh * 8);
        v4u qs; qs.x = cvtpk(bflo(w.x) * C1, bfhi(w.x) * C1); qs.y = cvtpk(bflo(w.y) * C1, bfhi(w.y) * C1); qs.z = cvtpk(bflo(w.z) * C1, bfhi(w.z) * C1); qs.w = cvtpk(bflo(w.w) * C1, bfhi(w.w) * C1);
        qf[d0] = __builtin_bit_cast(bf16x8, qs); }
    const float g_c = sigmoidf_(bf2f(T.z[zrow + C_GT + head * 3 + 0])), g_s = sigmoidf_(bf2f(T.z[zrow + C_GT + head * 3 + 1])), g_w = sigmoidf_(bf2f(T.z[zrow + C_GT + head * 3 + 2]));
    f32x16 yacc[2];
#pragma unroll
    for (int i = 0; i < 16; ++i) { yacc[0][i] = 0.f; yacc[1][i] = 0.f; }
    const bool two = (qt >= 16);
    { const int skey = tid >> 3, sch = tid & 7;
      const bf16* kc = T.kcvc + (size_t)((b * 4 + g) * 128) * 64, *vc = kc + (size_t)64 * 128 * 64;
      const int nt = two ? 2 : 1;
      for (int tt = 0; tt < nt; ++tt) {
          *(LAS v4u*)(lds + L_K + tt * KBUF + skey * KPB + sch * 16) = *(const v4u*)(kc + (size_t)(tt * 64 + skey) * 64 + sch * 8);
          *(LAS v4u*)(lds + L_V + tt * VBUF + skey * VPB + sch * 16) = *(const v4u*)(vc + (size_t)(tt * 64 + skey) * 64 + sch * 8);
      } }
    LAS unsigned* PSUMU = (LAS unsigned*)(lds + L_PSUM);
    if (two) { for (int u = tid; u < 128 * 65; u += 512) PSUMU[u] = 0u; }
    __syncthreads();
    const LAS float* biasr = BIAS + r * 128; const float bfar = biasr[127];
    NSA_MARK(0);
    { const int nt = two ? 2 : 1;
      float negm = 0.f, lacc = 0.f; f32x16 o[2];
#pragma unroll
      for (int i = 0; i < 16; ++i) { o[0][i] = 0.f; o[1][i] = 0.f; }
#pragma unroll 1
      for (int tt = 0; tt < nt; ++tt)
          tile_step<16, true>(lds + L_K + tt * KBUF, lds + L_V + tt * VBUF, qf, negm, o, lacc, tt == 0, true, bfar, tq - 31 - tt * 1024, 0x7fffffff, biasr, lane);
      const float lsum = lacc + __shfl_xor(lacc, 32);
      const float sc = (tq >= 31) ? g_c * __builtin_amdgcn_rcpf(lsum) : 0.f;
#pragma unroll
      for (int i = 0; i < 16; ++i) { yacc[0][i] = sc * o[0][i]; yacc[1][i] = sc * o[1][i]; }
      if (two) {
          const int qc = qh * 32 + r32; const float fx = 268435456.0f / lsum;
#pragma unroll 1
          for (int tt = 0; tt < 2; ++tt) {
              f32x16 a0, a1;
              qk_tile(a0, a1, lds + L_K + tt * KBUF, qf, r32, hh);
              gen_fix<16>(a0, a1, tq - 31 - tt * 1024, 0x7fffffff, true, negm, biasr, hh);
              LAS unsigned* pb = PSUMU + (tt * 64 + 4 * hh) * 65 + qc;
#pragma unroll
              for (int i = 0; i < 16; ++i) { const int ci = (i & 3) + 8 * (i >> 2);
                  __hip_atomic_fetch_add(pb + ci * 65, (unsigned)(__builtin_amdgcn_exp2f(a0[i]) * fx + 0.5f), __ATOMIC_RELAXED, __HIP_MEMORY_SCOPE_WORKGROUP);
                  __hip_atomic_fetch_add(pb + (ci + 32) * 65, (unsigned)(__builtin_amdgcn_exp2f(a1[i]) * fx + 0.5f), __ATOMIC_RELAXED, __HIP_MEMORY_SCOPE_WORKGROUP); }
          }
      }
    }
    __syncthreads();
    NSA_MARK(1);
    if (two) {
#pragma unroll 1
        for (int ps = 0; ps < 4; ++ps) {
            const int q = ps * 16 + 2 * wid + hh, j = r32;
            const int dblk = qt - j;
            float v;
            if (j == 0 || (dblk >= 0 && dblk < 2)) v = 1.0e4f;
            else if (dblk < 0) v = -1.0e4f;
            else { const LAS unsigned* pc = PSUMU + (4 * j) * 65 + q; v = ((float)pc[-65] + 2.f * (float)pc[0] + 2.f * (float)pc[65] + 2.f * (float)pc[130] + (float)pc[195]) * (1.0f / 268435456.0f); }
            IMPV[q * 32 + j] = v;
        }
        __syncthreads();
#pragma unroll 1
        for (int ps = 0; ps < 4; ++ps) {
            const int q = ps * 16 + 2 * wid + hh, j = r32;
            const float v = IMPV[q * 32 + j]; int rank = 0;
#pragma unroll
            for (int jj = 0; jj < 32; ++jj) { const float o = IMPV[q * 32 + jj]; rank += (o > v || (o == v && jj < j)) ? 1 : 0; }
            const unsigned long long bal = __ballot(rank < 16);
            if (r32 == 0) SEL[q] = hh ? (unsigned)(bal >> 32) : (unsigned)bal;
        }
        __syncthreads();
    }
    const unsigned selmask = two ? SEL[qh * 32 + r32] : 0xffffffffu;
    __syncthreads();
    NSA_MARK(2);
    LAS char* stash = lds + L_STASH + wid * 8192 + lane * 16;
#pragma unroll
    for (int db = 0; db < 2; ++db)
#pragma unroll
        for (int i4 = 0; i4 < 4; ++i4) *(LAS f32x4*)(stash + (db * 4 + i4) * 1024) = (f32x4){yacc[db][4 * i4], yacc[db][4 * i4 + 1], yacc[db][4 * i4 + 2], yacc[db][4 * i4 + 3]};
    branches(lds, T, b, g, qt, tq, qf, biasr, bfar, selmask, g_s, g_w, stash, tid, lane);
    NSA_MARK(3);
#pragma unroll
    for (int db = 0; db < 2; ++db)
#pragma unroll
        for (int i4 = 0; i4 < 4; ++i4) { const f32x4 y = *(const LAS f32x4*)(stash + (db * 4 + i4) * 1024); yacc[db][4 * i4] = y.x; yacc[db][4 * i4 + 1] = y.y; yacc[db][4 * i4 + 2] = y.z; yacc[db][4 * i4 + 3] = y.w; }
    { int tid2 = threadIdx.x; asm volatile("" : "+v"(tid2));
      const int tq2 = t0 + ((tid2 >> 6) & 1) * 32 + (tid2 & 31);
      bf16* yp = T.y + (size_t)(b * SEQ + tq2) * DM + LRUW + (g * 4 + (tid2 >> 7)) * 64;
      float ss = 0.f;
#pragma unroll
      for (int db = 0; db < 2; ++db)
#pragma unroll
          for (int i4 = 0; i4 < 4; ++i4) {
              const float v0 = yacc[db][4 * i4], v1 = yacc[db][4 * i4 + 1], v2 = yacc[db][4 * i4 + 2], v3 = yacc[db][4 * i4 + 3];
              ss += (v0 * v0 + v1 * v1) + (v2 * v2 + v3 * v3);
              v2u w; w.x = cvtpk(v0, v1); w.y = cvtpk(v2, v3);
              *(v2u*)(yp + db * 32 + 8 * i4 + 4 * hh) = w;
          }
      ss += __shfl_xor(ss, 32);
      if (hh == 0) SSQ[r * 64 + qh * 32 + r32] = ss;
      __syncthreads();
      if (tid < 64) T.ssn[(size_t)(b * SEQ + t0 + tid) * 4 + g] = (SSQ[tid] + SSQ[64 + tid]) + (SSQ[128 + tid] + SSQ[192 + tid]);
      __syncthreads(); }
    NSA_MARK(4);
}
#undef NSA_MFMA
}
namespace lru {
constexpr int TC = 128;
constexpr int L_XF = 0, L_AF = 32768, L_XB = 65536, XBP = 144, L_SEG = L_XB + TC * XBP, L_CARRY = L_SEG + 4096, L_SQ = L_CARRY + 256, L_END = L_SQ + TC * 65 * 4;
static_assert(L_END <= RING_BYTES, "lru LDS");
typedef float f32x4_ __attribute__((ext_vector_type(4)));
struct Tens { const bf16* z; const float *conv_w, *conv_b, *wa, *ba, *wx, *bx, *lam; bf16* y; float* ssl; };

__device__ __forceinline__ void unit(LAS char* lds, const Tens& T, int b, int n) {
    const int tid = threadIdx.x, lane = tid & 63, w = __builtin_amdgcn_readfirstlane(tid >> 6);
    const int c = lane, ch = n * 64 + c;
    LAS float* XF = (LAS float*)(lds + L_XF); LAS float* AF = (LAS float*)(lds + L_AF);
    LAS float* SEGA = (LAS float*)(lds + L_SEG); LAS float* SEGH = SEGA + 512;
    LAS float* CARRY = (LAS float*)(lds + L_CARRY); LAS float* YSQ = (LAS float*)(lds + L_SQ);
    const float cw0 = T.conv_w[ch], cw1 = T.conv_w[1024 + ch], cw2 = T.conv_w[2048 + ch], cw3 = T.conv_w[3072 + ch], cb = T.conv_b[ch];
    bf16x8 fwa[4][2], fwx[4][2]; float bar[4], bxr[4], clc[4];
    { const int kq = lane >> 4, jc = lane & 15;
#pragma unroll
      for (int cb4 = 0; cb4 < 4; ++cb4) {
          const int col = 16 * cb4 + jc;
#pragma unroll
          for (int ks = 0; ks < 2; ++ks) {
              unsigned short ea[8], ex[8];
#pragma unroll
              for (int e = 0; e < 8; ++e) { const size_t o = (size_t)n * 4096 + (size_t)(8 * kq + e + 32 * ks) * 64 + col; ea[e] = (unsigned short)f2bf(T.wa[o]); ex[e] = (unsigned short)f2bf(T.wx[o]); }
              fwa[cb4][ks] = (bf16x8){(short)ea[0], (short)ea[1], (short)ea[2], (short)ea[3], (short)ea[4], (short)ea[5], (short)ea[6], (short)ea[7]};
              fwx[cb4][ks] = (bf16x8){(short)ex[0], (short)ex[1], (short)ex[2], (short)ex[3], (short)ex[4], (short)ex[5], (short)ex[6], (short)ex[7]};
          }
          bar[cb4] = T.ba[n * 64 + col]; bxr[cb4] = T.bx[n * 64 + col];
          const float lm = T.lam[n * 64 + col];
          clc[cb4] = -8.0f * log1pf(expf(-lm)) * LOG2E;
      } }
    if (tid < 64) CARRY[tid] = 0.f;
    const bf16* zu = T.z + (size_t)b * SEQ * ZP + C_U + ch;
    const bf16* zg = T.z + (size_t)b * SEQ * ZP + C_GL + ch;
#pragma unroll 1
    for (int chunk = 0; chunk < SEQ / TC; ++chunk) {
        const int tb = chunk * TC + 16 * w;
        unsigned short gl[16];
#pragma unroll
        for (int i = 0; i < 16; ++i) gl[i] = zg[(size_t)(tb + i) * ZP];
        float uu[19];
#pragma unroll
        for (int k = 0; k < 19; ++k) { const int t = tb - 3 + k; uu[k] = (t >= 0) ? bf2f(zu[(size_t)t * ZP]) : 0.f; }
#pragma unroll
        for (int i = 0; i < 16; ++i) {
            const float xc = cb + cw0 * uu[i] + cw1 * uu[i + 1] + cw2 * uu[i + 2] + cw3 * uu[i + 3];
            XF[(16 * w + i) * 64 + c] = xc;
            *(LAS unsigned short*)(lds + L_XB + (16 * w + i) * XBP + c * 2) = (unsigned short)f2bf(xc);
        }
        __syncthreads();
        { const int kq = lane >> 4, jc = lane & 15;
          const bf16x8 fa0 = *(const LAS bf16x8*)(lds + L_XB + (16 * w + jc) * XBP + (8 * kq) * 2), fa1 = *(const LAS bf16x8*)(lds + L_XB + (16 * w + jc) * XBP + (8 * kq + 32) * 2);
#pragma unroll
          for (int cb4 = 0; cb4 < 4; ++cb4) {
              f32x4_ ar = {0.f, 0.f, 0.f, 0.f}, ax = {0.f, 0.f, 0.f, 0.f};
              ar = __builtin_amdgcn_mfma_f32_16x16x32_bf16(fa0, fwa[cb4][0], ar, 0, 0, 0); ar = __builtin_amdgcn_mfma_f32_16x16x32_bf16(fa1, fwa[cb4][1], ar, 0, 0, 0);
              ax = __builtin_amdgcn_mfma_f32_16x16x32_bf16(fa0, fwx[cb4][0], ax, 0, 0, 0); ax = __builtin_amdgcn_mfma_f32_16x16x32_bf16(fa1, fwx[cb4][1], ax, 0, 0, 0);
              const int col = 16 * cb4 + jc;
#pragma unroll
              for (int e = 0; e < 4; ++e) {
                  const int tt = 16 * w + 4 * kq + e;
                  const float rg = sigmoidf_(ar[e] + bar[cb4]), ig = sigmoidf_(ax[e] + bxr[cb4]);
                  const float a = __builtin_amdgcn_exp2f(clc[cb4] * rg);
                  const float xcv = XF[tt * 64 + col];
                  AF[tt * 64 + col] = a;
                  XF[tt * 64 + col] = __builtin_amdgcn_sqrtf(fmaxf(1.0f - a * a, 0.f)) * (ig * xcv);
              }
          } }
        __syncthreads();
        float av[16], bv[16];
#pragma unroll
        for (int i = 0; i < 16; ++i) { av[i] = AF[(16 * w + i) * 64 + c]; bv[i] = XF[(16 * w + i) * 64 + c]; }
        { float A = 1.f, H = 0.f;
#pragma unroll
          for (int i = 0; i < 16; ++i) { H = av[i] * H + bv[i]; A *= av[i]; }
          SEGA[w * 64 + c] = A; SEGH[w * 64 + c] = H; }
        __syncthreads();
        float h = CARRY[c];
        for (int s = 0; s < w; ++s) h = SEGA[s * 64 + c] * h + SEGH[s * 64 + c];
        bf16* yp = T.y + (size_t)(b * SEQ + tb) * DM + ch;
#pragma unroll
        for (int i = 0; i < 16; ++i) {
            h = av[i] * h + bv[i];
            const float yv = h * pg8::gelu_tanh(bf2f(gl[i]));
            yp[(size_t)i * DM] = (bf16)f2bf(yv);
            YSQ[(16 * w + i) * 65 + c] = yv * yv;
        }
        __syncthreads();
        if (w == 7) CARRY[c] = h;
        if (tid < TC) { float s = 0.f;
#pragma unroll 8
            for (int k = 0; k < 64; ++k) s += YSQ[tid * 65 + k];
            T.ssl[(size_t)(b * SEQ + chunk * TC + tid) * 16 + n] = s; }
    }
    __syncthreads();
}
}
struct Frame {
    LAS unsigned char* lds; volatile LAS unsigned* MISC; gu32* ctl;
    int tid, lane, wave, vcu, G;
};
struct Args { const float* in[28]; float* out; unsigned char* ws; int ph_lo, ph_hi; };

__device__ __forceinline__ void p0_transpose_item(const float* W, int K, int N, int NP, bf16* WT, LAS float* scr, int item, int lane, const float* kscale = nullptr) {
    const int nblk = NP / 32, kb = item / nblk, nb = item % nblk, k0 = 64 * kb, n0 = 32 * nb;
    const int nn = n0 + (lane & 31);
    float wv[32];
#pragma unroll
    for (int i = 0; i < 32; ++i) { const int kk = 2 * i + (lane >> 5); wv[i] = (nn < N) ? W[(size_t)(k0 + kk) * N + nn] : 0.f; }
    if (kscale) {
#pragma unroll
        for (int i = 0; i < 32; ++i) wv[i] *= kscale[k0 + 2 * i + (lane >> 5)]; }
#pragma unroll
    for (int i = 0; i < 32; ++i) scr[(2 * i + (lane >> 5)) * 33 + (lane & 31)] = wv[i];
    LDS_WAIT(); asm volatile("" ::: "memory");
    const int c = lane & 7;
#pragma unroll
    for (int j = 0; j < 4; ++j) { const int n = (lane >> 3) + 8 * j; const LAS float* s = scr + (8 * c) * 33 + n;
        v4u o; o.x = pk2(s[0 * 33], s[1 * 33]); o.y = pk2(s[2 * 33], s[3 * 33]); o.z = pk2(s[4 * 33], s[5 * 33]); o.w = pk2(s[6 * 33], s[7 * 33]);
        *(GAS v4u*)(WT + (size_t)(n0 + n) * K + k0 + 8 * c) = o; }
    LDS_WAIT(); asm volatile("" ::: "memory");
}
__device__ __forceinline__ void rms_row_to_bf16(const float* xrow, const float* g, bf16* orow, int lane) {
    f32x4 v[8]; float s = 0.f;
#pragma unroll
    for (int j = 0; j < 8; ++j) { v[j] = *(const f32x4*)(xrow + 4 * (lane + 64 * j)); s += (v[j].x * v[j].x + v[j].y * v[j].y) + (v[j].z * v[j].z + v[j].w * v[j].w); }
    const float rs = 1.0f / sqrtf(wave_sum(s) * (1.0f / DM) + NORM_EPS);
#pragma unroll
    for (int j = 0; j < 8; ++j) { const f32x4 gg = *(const f32x4*)(g + 4 * (lane + 64 * j)); v2u o; o.x = pk2(v[j].x * rs * gg.x, v[j].y * rs * gg.y); o.y = pk2(v[j].z * rs * gg.z, v[j].w * rs * gg.w);
        *(v2u*)(orow + 4 * (lane + 64 * j)) = o; }
}

__global__ void __launch_bounds__(NWAVES * 64, 2) hymba_fwd(Args args) {
    extern __shared__ __attribute__((aligned(16))) unsigned char lds[];
    Frame F;
    F.lds = (LAS unsigned char*)lds; F.MISC = (volatile LAS unsigned*)(F.lds + MISC_OFF);
    F.tid = threadIdx.x; F.lane = F.tid & 63; F.wave = __builtin_amdgcn_readfirstlane(F.tid >> 6);
    F.G = gridDim.x; { const int bx = blockIdx.x; F.vcu = (F.G % 8 == 0) ? (bx % 8) * (F.G / 8) + bx / 8 : bx; }
    unsigned char* ws = args.ws;
    F.ctl = (gu32*)(ws + WS_CTL);
    for (int u = F.tid; u < (LDS_BYTES - LDSCTL_OFF) / 4; u += NWAVES * 64) ((LAS unsigned*)(F.lds + LDSCTL_OFF))[u] = 0u;
    __syncthreads();
    XcdBarrier bar = xcd_barrier_post((unsigned*)(F.ctl + CW_BAR), F.MISC + 8);
    const int lo = args.ph_lo, hi = args.ph_hi;
#ifndef PHMASK
#define PHMASK 0xfff
#endif
#define IN(k) (((PHMASK >> (k)) & 1) && lo <= (k) && (k) < hi)
#ifndef REP_MASK
#define REP_MASK 0
#endif
#ifndef PROBE_MODE
#define PROBE_MODE 0
#endif
#ifndef PROBE_PH
#define PROBE_PH 8
#endif
#define TS ((volatile LAS unsigned long long*)(LDSCTL_OFF + 1024))
#define STAMP(k) do { if (PROBE_MODE && blockIdx.x == 0 && F.tid == 0) { TS[2 * (k)] = __builtin_amdgcn_s_memrealtime(); TS[2 * (k) + 1] = (unsigned long long)clock64(); } } while (0)
#define PH_BEGIN(k) if (IN(k)) { STAMP(k); for (int rep_ = 0; rep_ < ((REP_MASK >> (k)) & 1) + 1; ++rep_) { if (rep_) xcd_barrier(bar);
#define PH_END() } }
#define SEAM(k) do { if (IN(k) && IN((k) + 1)) xcd_barrier(bar); } while (0)
#define x_in (args.in[0])
#define p_in (args.in[1])
#define g_mix_pre (args.in[2])
#define g_mix_post (args.in[3])
#define g_mlp_pre (args.in[4])
#define g_mlp_post (args.in[5])
#define w_in (args.in[6])
#define conv_w (args.in[7])
#define conv_b (args.in[8])
#define lru_wa (args.in[9])
#define lru_ba (args.in[10])
#define lru_wx (args.in[11])
#define lru_bx (args.in[12])
#define lru_lam (args.in[13])
#define pe_k (args.in[14])
#define cw1_k (args.in[15])
#define cw2_k (args.in[16])
#define pe_v (args.in[17])
#define cw1_v (args.in[18])
#define cw2_v (args.in[19])
#define rel_bias (args.in[20])
#define gn_lru (args.in[21])
#define gn_nsa (args.in[22])
#define w_out (args.in[23])
#define mlp_w1 (args.in[24])
#define mlp_w2 (args.in[25])
#define ple_gate (args.in[26])
#define ple_proj (args.in[27])
    float* out = args.out;
    bf16 *Win_t = (bf16*)(ws + WS_WIN), *Wout_t = (bf16*)(ws + WS_WOUT), *W1_t = (bf16*)(ws + WS_W1), *W2_t = (bf16*)(ws + WS_W2), *Wg_t = (bf16*)(ws + WS_WG), *Wp_t = (bf16*)(ws + WS_WP);
    bf16 *Cw1k_t = (bf16*)(ws + WS_CW1K), *Cw1v_t = (bf16*)(ws + WS_CW1V);
    float* b1part = (float*)(ws + WS_MISC); float* bias1 = (float*)(ws + WS_MISC + 65536); float* RS = (float*)(ws + WS_MISC + 131072);
    bf16* PB = (bf16*)(ws + WS_PB); bf16* HID = (bf16*)(ws + WS_HID); bf16* KCVC = (bf16*)(ws + WS_KCVC);
    float *SSL = (float*)(ws + WS_SSL), *SSN = (float*)(ws + WS_SSN), *SSQ = (float*)(ws + WS_SSQ);
    bf16* XB = (bf16*)(ws + WS_A);
    float* RSX = (float*)(ws + WS_MISC + 262144);
    bf16 *A = (bf16*)(ws + WS_A), *Z = (bf16*)(ws + WS_Z), *Y = (bf16*)(ws + WS_Y), *TT = (bf16*)(ws + WS_T), *HID2 = (bf16*)(ws + WS_HID2), *FF = (bf16*)(ws + WS_F), *PP = (bf16*)(ws + WS_PP);
    const int gw = F.vcu * NWAVES + F.wave, NGW = F.G * NWAVES;

    PH_BEGIN(0)
        LAS float* scr = (LAS float*)(F.lds + RING_OFF + F.wave * 16384);
        constexpr int I_IN = (DM / 64) * (ZP / 32), I_OUT = (DM / 64) * (DM / 32), I_1 = (DM / 64) * (DFF / 32), I_2 = (DFF / 64) * (DM / 32), I_G = I_OUT, I_P = (PLE / 64) * (DM / 32), I_C = (CMP_K / 64) * (CMP_H / 32);
        constexpr int NITEMS = I_IN + I_OUT + I_1 + I_2 + I_G + I_P + 2 * I_C;
        for (int it = gw; it < NITEMS; it += NGW) {
            int r = it;
            if (r < I_IN) { p0_transpose_item(w_in, DM, IN_DIM, ZP, Win_t, scr, r, F.lane, g_mix_pre); continue; } r -= I_IN;
            if (r < I_OUT) { p0_transpose_item(w_out, DM, DM, DM, Wout_t, scr, r, F.lane, (r / (DM / 32)) < 16 ? gn_lru : gn_nsa - LRUW); continue; } r -= I_OUT;
            if (r < I_1) { p0_transpose_item(mlp_w1, DM, DFF, DFF, W1_t, scr, r, F.lane, g_mlp_pre); continue; } r -= I_1;
            if (r < I_2) { p0_transpose_item(mlp_w2, DFF, DM, DM, W2_t, scr, r, F.lane); continue; } r -= I_2;
            if (r < I_G) { p0_transpose_item(ple_gate, DM, DM, DM, Wg_t, scr, r, F.lane); continue; } r -= I_G;
            if (r < I_P) { p0_transpose_item(ple_proj, PLE, DM, DM, Wp_t, scr, r, F.lane); continue; } r -= I_P;
            if (r < I_C) { p0_transpose_item(cw1_k, CMP_K, CMP_H, CMP_H, Cw1k_t, scr, r, F.lane); continue; } r -= I_C;
            p0_transpose_item(cw1_v, CMP_K, CMP_H, CMP_H, Cw1v_t, scr, r, F.lane);
        }
        for (int m = gw; m < MTOK; m += 2 * NGW) {
            const int m2 = m + NGW; const bool h2 = m2 < MTOK; const float* x0 = x_in + (size_t)m * DM; const float* x1 = x_in + (size_t)(h2 ? m2 : m) * DM;
            f32x4 v0[8], v1[8]; float s0 = 0.f, s1 = 0.f;
#pragma unroll
            for (int j = 0; j < 8; ++j) { v0[j] = *(const f32x4*)(x0 + 4 * (F.lane + 64 * j)); v1[j] = *(const f32x4*)(x1 + 4 * (F.lane + 64 * j)); }
#pragma unroll
            for (int j = 0; j < 8; ++j) { s0 += (v0[j].x * v0[j].x + v0[j].y * v0[j].y) + (v0[j].z * v0[j].z + v0[j].w * v0[j].w); s1 += (v1[j].x * v1[j].x + v1[j].y * v1[j].y) + (v1[j].z * v1[j].z + v1[j].w * v1[j].w);
                v2u o; o.x = pk2(v0[j].x, v0[j].y); o.y = pk2(v0[j].z, v0[j].w); *(v2u*)(XB + (size_t)m * DM + 4 * (F.lane + 64 * j)) = o;
                if (h2) { v2u q; q.x = pk2(v1[j].x, v1[j].y); q.y = pk2(v1[j].z, v1[j].w); *(v2u*)(XB + (size_t)m2 * DM + 4 * (F.lane + 64 * j)) = q; } }
            s0 = wave_sum(s0); s1 = wave_sum(s1);
            if (F.lane == 0) { RSX[m] = 1.0f / sqrtf(s0 * (1.0f / DM) + NORM_EPS); if (h2) RSX[m2] = 1.0f / sqrtf(s1 * (1.0f / DM) + NORM_EPS); }
        }
        for (int m = gw; m < MTOK; m += 4 * NGW) { f32x4 v[4];
#pragma unroll
            for (int u = 0; u < 4; ++u) { const int mm = m + u * NGW; v[u] = *(const f32x4*)(p_in + (size_t)(mm < MTOK ? mm : m) * PLE + 4 * F.lane); }
#pragma unroll
            for (int u = 0; u < 4; ++u) { const int mm = m + u * NGW; if (mm < MTOK) { v2u o; o.x = pk2(v[u].x, v[u].y); o.y = pk2(v[u].z, v[u].w); *(v2u*)(PB + (size_t)mm * PLE + 4 * F.lane) = o; } } }
        for (int it = gw; it < 256; it += NGW) {
            const int ten = it >> 7, ks = (it >> 3) & 15, cg = it & 7, col = cg * 32 + (F.lane & 31), kh = F.lane >> 5;
            const float* pe = ten ? pe_v : pe_k; const float* w1 = ten ? cw1_v : cw1_k; float s = 0.f;
            for (int k = 0; k < 64; ++k) { const int kk = ks * 128 + kh * 64 + k; s += pe[kk] * w1[(size_t)kk * CMP_H + col]; }
            s += __shfl_xor(s, 32);
            if (kh == 0) b1part[(ten * 16 + ks) * 256 + col] = s;
        }
    PH_END()
    SEAM(0);
    PH_BEGIN(1)
        if (blockIdx.x == 0) { const int ten = F.tid >> 8, col = F.tid & 255; float s = 0.f;
            for (int ks = 0; ks < 16; ++ks) s += b1part[(ten * 16 + ks) * 256 + col];
            bias1[ten * 256 + col] = s; }
        pg8::Gemm g{XB, Win_t, MTOK, ZP, DM}; pg8::StaticOrder S; S.init(MTOK, ZP, F.G, (int)blockIdx.x);
        pg8::EpiAct<0> E{Z, ZP, nullptr, RSX};
        pg8::gemm_phase<pg8::EpiAct<0>, pg8::StaticOrder, pg8::AMapPlain, true, true>(F.lds + RING_OFF, g, S, E);
    PH_END()
    SEAM(1);
    PH_BEGIN(2)
        { lru::Tens T{Z, conv_w, conv_b, lru_wa, lru_ba, lru_wx, lru_bx, lru_lam, Y, SSL};
          for (int u = F.vcu; u < BATCH * 16; u += F.G) lru::unit((LAS char*)F.lds, T, u >> 4, u & 15); }
        { pg8::Gemm g{Z + C_KC, Cw1k_t, 8192, CMP_H, CMP_K}; pg8::StaticOrder S; S.init(8192, CMP_H, F.G, (int)blockIdx.x);
          pg8::EpiAct<2> E{HID, CMP_H, bias1, nullptr};
          pg8::gemm_phase<pg8::EpiAct<2>, pg8::StaticOrder, pg8::AMapCmp, false, true>(F.lds + RING_OFF, g, S, E); }
        __syncthreads();
        { pg8::Gemm g{Z + C_VC, Cw1v_t, 8192, CMP_H, CMP_K}; pg8::StaticOrder S; S.init(8192, CMP_H, F.G, (int)((blockIdx.x + 128) % F.G));
          pg8::EpiAct<2> E{HID + (size_t)8192 * CMP_H, CMP_H, bias1 + 256, nullptr};
          pg8::gemm_phase<pg8::EpiAct<2>, pg8::StaticOrder, pg8::AMapCmp, false, true>(F.lds + RING_OFF, g, S, E); }
    PH_END()
    SEAM(2);
    PH_BEGIN(3)
        for (int it = F.vcu * 512 + F.tid; it < 2 * 8192 * 8; it += F.G * 512) {
            const int row = it >> 3, c8 = it & 7, ten = row >> 13;
            const float* w2 = (ten ? cw2_v : cw2_k) + c8 * 8;
            float acc[8] = {0.f, 0.f, 0.f, 0.f, 0.f, 0.f, 0.f, 0.f};
            if ((row & 127) != 127) {
                const bf16* hp = HID + (size_t)row * CMP_H;
                for (int k8 = 0; k8 < 32; ++k8) {
                    const v4u hw = *(const v4u*)(hp + k8 * 8); const unsigned hu[4] = {hw.x, hw.y, hw.z, hw.w};
#pragma unroll
                    for (int e = 0; e < 8; ++e) { const float hv = (e & 1) ? bfhi(hu[e >> 1]) : bflo(hu[e >> 1]);
                        const f32x4 wa = *(const f32x4*)(w2 + (size_t)(k8 * 8 + e) * 64), wb = *(const f32x4*)(w2 + (size_t)(k8 * 8 + e) * 64 + 4);
                        acc[0] += hv * wa.x; acc[1] += hv * wa.y; acc[2] += hv * wa.z; acc[3] += hv * wa.w; acc[4] += hv * wb.x; acc[5] += hv * wb.y; acc[6] += hv * wb.z; acc[7] += hv * wb.w; }
                }
            }
            v4u o; o.x = pk2(acc[0], acc[1]); o.y = pk2(acc[2], acc[3]); o.z = pk2(acc[4], acc[5]); o.w = pk2(acc[6], acc[7]);
            *(v4u*)(KCVC + (size_t)row * 64 + c8 * 8) = o;
        }
    PH_END()
    SEAM(3);
    PH_BEGIN(4)
        nsa::Tens T{Z, KCVC, rel_bias, Y, SSN};
        for (int v = F.vcu; v < 256; v += F.G) {
            const int bg = v >> 2, k = v & 3;
            __syncthreads(); nsa::fill_bias((LAS char*)F.lds, rel_bias, bg & 3);
#pragma unroll 1
            for (int i = 7; i >= 0; --i) { const int qt = 8 * (i >> 1) + ((i & 1) ? 7 - k : k); nsa::unit((LAS char*)F.lds, T, bg >> 2, bg & 3, qt); }
        }
    PH_END()
    SEAM(4);
    PH_BEGIN(6)
        pg8::Gemm g{Y, Wout_t, MTOK, DM, DM}; pg8::StaticOrder S; S.init(MTOK, DM, F.G, (int)blockIdx.x);
        LAS float* tab = (LAS float*)(F.lds + LDSCTL_OFF + 4096);
        for (int i = F.wave >> 2; i < 4; i += 2) { pg8::Unit u;
            if (S.next(i, u)) { const int r = F.tid & 255; const size_t row = (size_t)u.pm * 256 + r;
                const f32x4 a0 = *(const f32x4*)(SSL + row * 16), a1 = *(const f32x4*)(SSL + row * 16 + 4), a2 = *(const f32x4*)(SSL + row * 16 + 8), a3 = *(const f32x4*)(SSL + row * 16 + 12), n0 = *(const f32x4*)(SSN + row * 4);
                const float sl = ((a0.x + a0.y) + (a0.z + a0.w)) + ((a1.x + a1.y) + (a1.z + a1.w)) + ((a2.x + a2.y) + (a2.z + a2.w)) + ((a3.x + a3.y) + (a3.z + a3.w)), sn = (n0.x + n0.y) + (n0.z + n0.w);
                const float rl = 1.0f / sqrtf(sl * (1.0f / 1024.f) + NORM_EPS), rn = 1.0f / sqrtf(sn * (1.0f / 1024.f) + NORM_EPS);
                tab[(i * 256 + r) * 2] = rl / rn; tab[(i * 256 + r) * 2 + 1] = rn; } }
        __syncthreads();
        pg8::EpiSsqY E{TT, DM, SSQ, tab};
        pg8::gemm_phase<pg8::EpiSsqY, pg8::StaticOrder, pg8::AMapPlain, true, true>(F.lds + RING_OFF, g, S, E);
    PH_END()
    SEAM(6);
    PH_BEGIN(7)
        for (int m = gw; m < MTOK; m += NGW) {
            float sq = (F.lane < 32) ? SSQ[(size_t)m * 32 + F.lane] : 0.f; sq = wave_sum(sq);
            const float rt = 1.0f / sqrtf(sq * (1.0f / DM) + NORM_EPS);
            const bf16* tr = TT + (size_t)m * DM; const bf16* xr = XB + (size_t)m * DM; bf16* ar = A + (size_t)m * DM;
            float s2 = 0.f;
#pragma unroll
            for (int j = 0; j < 4; ++j) { const int c0 = 8 * (F.lane + 64 * j);
                const v4u w = *(const v4u*)(tr + c0), xw = *(const v4u*)(xr + c0); const f32x4 g0 = *(const f32x4*)(g_mix_post + c0), g1 = *(const f32x4*)(g_mix_post + c0 + 4);
                const f32x4 x0 = {bflo(xw.x), bfhi(xw.x), bflo(xw.y), bfhi(xw.y)}, x1 = {bflo(xw.z), bfhi(xw.z), bflo(xw.w), bfhi(xw.w)};
                f32x4 h0, h1;
                h0.x = x0.x + bflo(w.x) * rt * g0.x; h0.y = x0.y + bfhi(w.x) * rt * g0.y; h0.z = x0.z + bflo(w.y) * rt * g0.z; h0.w = x0.w + bfhi(w.y) * rt * g0.w;
                h1.x = x1.x + bflo(w.z) * rt * g1.x; h1.y = x1.y + bfhi(w.z) * rt * g1.y; h1.z = x1.z + bflo(w.w) * rt * g1.z; h1.w = x1.w + bfhi(w.w) * rt * g1.w;
                s2 += (h0.x * h0.x + h0.y * h0.y) + (h0.z * h0.z + h0.w * h0.w); s2 += (h1.x * h1.x + h1.y * h1.y) + (h1.z * h1.z + h1.w * h1.w);
                v4u o; o.x = pk2(h0.x, h0.y); o.y = pk2(h0.z, h0.w); o.z = pk2(h1.x, h1.y); o.w = pk2(h1.z, h1.w);
                *(v4u*)(ar + c0) = o; }
            s2 = wave_sum(s2);
            if (F.lane == 0) RS[m] = 1.0f / sqrtf(s2 * (1.0f / DM) + NORM_EPS);
        }
    PH_END()
    SEAM(7);
    PH_BEGIN(8)
        pg8::Gemm g{A, W1_t, MTOK, DFF, DM}; pg8::StaticOrder S; S.init(MTOK, DFF, F.G, (int)blockIdx.x);
        pg8::EpiAct<3> E{HID2, DFF, nullptr, RS};
        pg8::gemm_phase<pg8::EpiAct<3>, pg8::StaticOrder, pg8::AMapPlain, true, true>(F.lds + RING_OFF, g, S, E);
    PH_END()
    SEAM(8);
    PH_BEGIN(9)
        pg8::Gemm g{HID2, W2_t, MTOK, DM, DFF}; pg8::StaticOrder S; S.init(MTOK, DM, F.G, (int)blockIdx.x);
        pg8::EpiSsq E{FF, DM, SSQ};
        pg8::gemm_phase<pg8::EpiSsq, pg8::StaticOrder, pg8::AMapPlain, true, true>(F.lds + RING_OFF, g, S, E);
    PH_END()
    SEAM(9);
    PH_BEGIN(10)
        for (int m = gw; m < MTOK; m += NGW) {
            float sq = (F.lane < 32) ? SSQ[(size_t)m * 32 + F.lane] : 0.f; sq = wave_sum(sq);
            const float rf = 1.0f / sqrtf(sq * (1.0f / DM) + NORM_EPS);
            const bf16* fr_ = FF + (size_t)m * DM; bf16* ar = A + (size_t)m * DM;
#pragma unroll
            for (int j = 0; j < 4; ++j) { const int c0 = 8 * (F.lane + 64 * j);
                const v4u w = *(const v4u*)(fr_ + c0), hw = *(const v4u*)(ar + c0); const f32x4 g0 = *(const f32x4*)(g_mlp_post + c0), g1 = *(const f32x4*)(g_mlp_post + c0 + 4);
                v4u o; o.x = pk2(bflo(hw.x) + bflo(w.x) * rf * g0.x, bfhi(hw.x) + bfhi(w.x) * rf * g0.y); o.y = pk2(bflo(hw.y) + bflo(w.y) * rf * g0.z, bfhi(hw.y) + bfhi(w.y) * rf * g0.w);
                o.z = pk2(bflo(hw.z) + bflo(w.z) * rf * g1.x, bfhi(hw.z) + bfhi(w.z) * rf * g1.y); o.w = pk2(bflo(hw.w) + bflo(w.w) * rf * g1.z, bfhi(hw.w) + bfhi(w.w) * rf * g1.w);
                *(v4u*)(ar + c0) = o; }
        }
        VM_WAIT(); __syncthreads();
        int kple = PLE; asm volatile("" : "+s"(kple));
        pg8::Gemm g{PB, Wp_t, MTOK, DM, kple}; pg8::StaticOrder S; S.init(MTOK, DM, F.G, (int)blockIdx.x);
        pg8::EpiAct<0> E{PP, DM, nullptr, nullptr};
        pg8::gemm_phase<pg8::EpiAct<0>, pg8::StaticOrder, pg8::AMapPlain, true, true>(F.lds + RING_OFF, g, S, E);
    PH_END()
    SEAM(10);
    PH_BEGIN(11)
        pg8::Gemm g{A, Wg_t, MTOK, DM, DM}; pg8::StaticOrder S; S.init(MTOK, DM, F.G, (int)blockIdx.x);
        pg8::EpiGate E{out, A, PP, DM};
        pg8::gemm_phase<pg8::EpiGate, pg8::StaticOrder, pg8::AMapPlain, true, true>(F.lds + RING_OFF, g, S, E);
    PH_END()
#if PROBE_MODE
    STAMP(12);
    if (blockIdx.x == 0 && F.tid == 0) {
        const unsigned long long r0 = TS[2 * PROBE_PH], r1 = TS[2 * PROBE_PH + 2], c0 = TS[2 * PROBE_PH + 1], c1 = TS[2 * PROBE_PH + 3];
        unsigned long long ticks;
        if (PROBE_MODE >= 10) ticks = ((volatile LAS unsigned long long*)(LDSCTL_OFF + 1024 + 256))[PROBE_MODE - 10];
        else if (PROBE_MODE == 1) ticks = (c1 - c0) * 100ull / (r1 - r0) * 100ull;
        else ticks = (r1 - r0) * (unsigned long long)(PROBE_MODE - 1);
        const unsigned long long t0 = __builtin_amdgcn_s_memrealtime();
        while (__builtin_amdgcn_s_memrealtime() - t0 < ticks) __builtin_amdgcn_s_sleep(8);
    }
#endif
#undef IN
#undef SEAM
#undef x_in
#undef p_in
}

#ifndef MK_SPLIT
#define MK_SPLIT 0
#endif
extern "C" void kernel_launch(void* const* d_in, const int* in_sizes, int n_in, void* d_out, int out_size, void* d_ws, size_t ws_size, hipStream_t stream) {
    static int grid = 0;
    if (grid == 0) {
        if (n_in != 28 || out_size != MTOK * DM || ws_size < WS_END) { fprintf(stderr, "kernel_launch: unexpected shapes (n_in %d, out %d, ws %zu)\n", n_in, out_size, ws_size); grid = -1; return; }
        int dev = 0, cus = 0, per_cu = 0;
        if (hipGetDevice(&dev) != hipSuccess || hipDeviceGetAttribute(&cus, hipDeviceAttributeMultiprocessorCount, dev) != hipSuccess) { grid = -1; return; }
        if (hipFuncSetAttribute((const void*)hymba_fwd, hipFuncAttributeMaxDynamicSharedMemorySize, LDS_BYTES) != hipSuccess) { fprintf(stderr, "kernel_launch: hipFuncSetAttribute failed\n"); grid = -1; return; }
        if (hipOccupancyMaxActiveBlocksPerMultiprocessor(&per_cu, (const void*)hymba_fwd, NWAVES * 64, LDS_BYTES) != hipSuccess || per_cu < 1) { fprintf(stderr, "kernel_launch: occupancy query says %d\n", per_cu); (void)hipGetLastError(); }
        grid = cus;
    }
    if (grid < 0) return;
    (void)hipMemsetAsync((char*)d_ws + WS_CTL, 0, CTL_ZERO_BYTES, stream);
    Args a{};
    for (int i = 0; i < 28; ++i) a.in[i] = (const float*)d_in[i];
    a.out = (float*)d_out; a.ws = (unsigned char*)d_ws;
#if MK_SPLIT
    for (int ph = 0; ph < 12; ++ph) { a.ph_lo = ph; a.ph_hi = ph + 1; hipLaunchKernelGGL(hymba_fwd, dim3(grid), dim3(NWAVES * 64), LDS_BYTES, stream, a); }
#else
    a.ph_lo = 0; a.ph_hi = 12;
    hipLaunchKernelGGL(hymba_fwd, dim3(grid), dim3(NWAVES * 64), LDS_BYTES, stream, a);
#endif
}
```

```cpp
#include <hip/hip_runtime.h>
#include <cstdio>
#include <cstdint>

constexpr int BATCH = 16, SEQ = 2048, DM = 2048, MTOK = BATCH * SEQ;
constexpr int IN_DIM = 4656, ZP = 4864;
constexpr int C_U = 0, C_GL = 1024, C_Q = 2048, C_KC = 3072, C_VC = 3328, C_KS = 3584, C_VS = 3840, C_KW = 4096, C_VW = 4352, C_GT = 4608;
constexpr int DFF = 8192, PLE = 256, LRUW = 1024, NHEAD = 16, HD = 64, NKV = 4;
constexpr int NCMP = 127, NCMP_P = 128, CMP_K = 2048, CMP_H = 256;
constexpr float NORM_EPS = 1e-6f;
constexpr float LOG2E = 1.4426950408889634f;

namespace pg8 {
#define PG8_LAS __attribute__((address_space(3)))
typedef unsigned short bf16_t;
typedef short bf16x8 __attribute__((ext_vector_type(8)));
typedef float f32x4 __attribute__((ext_vector_type(4)));
typedef unsigned u32x4 __attribute__((ext_vector_type(4)));
constexpr int BM = 256, BK = 64, HALF = 128, HTB = HALF * BK * 2  , STAGE_BYTES = 8 * HTB, NXCD = 8, WGM = 8;

__host__ __device__ __forceinline__ int lds_byte(int r, int c) { const int st = (r >> 4) * 2 + (c >> 5), rr = r & 15, cc = c & 31, ob = rr * 64 + cc * 2; return st * 1024 + (ob ^ (((ob >> 9) & 1) << 5)); }
__host__ __device__ __forceinline__ void stage_rc(int b, int& R, int& C) { const int st = b / 1024, sb = b % 1024, swz = sb ^ (((sb >> 9) & 1) << 5); R = (st >> 1) * 16 + swz / 64; C = (st & 1) * 32 + (swz % 64) / 2; }
__host__ __device__ __forceinline__ int perm32(int rho) { const int n = rho >> 4, i = rho & 15; return 8 * (i >> 2) + 4 * n + (i & 3); }

struct Unit { int pm, pn; };
struct Gemm { const bf16_t* A; const bf16_t* Bt; int M, N, K; };

struct StaticOrder {
    int nM, nN, nwg, G, c;
    __host__ __device__ void init(int M, int N, int G_, int c_) { nM = M / BM; nN = N / BM; nwg = nM * nN; G = G_; c = c_; }
    __host__ __device__ __forceinline__ bool next(int i, Unit& u) const {
        const long L = (long)i * G + c; if (L >= nwg) return false;
        int wgid = (int)L; { const int q = nwg / NXCD, r = nwg % NXCD, xcd = wgid % NXCD, off = wgid / NXCD; wgid = (xcd < r ? xcd * (q + 1) : r * (q + 1) + (xcd - r) * q) + off; }
        const int nig = WGM * nN, gid = wgid / nig, fm = gid * WGM, gsz = (nM - fm) < WGM ? (nM - fm) : WGM;
        u.pm = fm + ((wgid % nig) % gsz); u.pn = (wgid % nig) / gsz; return true;
    }
    __device__ __forceinline__ void a_ready(const Unit&) const {}
    __device__ __forceinline__ void done(const Unit&) const {}
};

__device__ __forceinline__ unsigned cvt_pk_bf16(float lo, float hi) { unsigned r; asm volatile("v_cvt_pk_bf16_f32 %0, %1, %2" : "=v"(r) : "v"(lo), "v"(hi)); return r; }
struct AMapPlain {
    __device__ static __forceinline__ int lda(const Gemm& g) { return g.K; }
    __device__ static __forceinline__ int ldb(const Gemm& g) { return g.K; }
    __device__ static __forceinline__ size_t kstep(const Gemm&) { return (size_t)(BK * 2); }
    __device__ static __forceinline__ size_t hstep(const Gemm& g) { return (size_t)HALF * g.K * 2; }
    __device__ static __forceinline__ const char* base(const Gemm& g, const Unit& u) { return (const char*)g.A + (size_t)u.pm * 2 * HALF * g.K * 2; }
    __device__ static __forceinline__ const char* baseB(const Gemm& g, const Unit& u) { return (const char*)g.Bt + (size_t)u.pn * 2 * HALF * g.K * 2; }
};
struct AMapCmp4 {
    __device__ static __forceinline__ int lda(const Gemm&) { return 16 * ZP; }
    __device__ static __forceinline__ int ldb(const Gemm&) { return CMP_K; }
    __device__ static __forceinline__ size_t kstep(const Gemm&) { return (size_t)ZP * 2; }
    __device__ static __forceinline__ size_t hstep(const Gemm&) { return (size_t)128; }
    __device__ static __forceinline__ const char* base(const Gemm& g, const Unit& u) { const int ten = u.pm >> 7, ks = (u.pm >> 5) & 3, pm = u.pm & 31;
        return (const char*)g.A + ((size_t)(pm >> 1) * SEQ * ZP + (size_t)(ks * 8) * ZP + (ten ? C_VC : C_KC) + (size_t)(pm & 1) * 128) * 2; }
    __device__ static __forceinline__ const char* baseB(const Gemm& g, const Unit& u) { const int ten = u.pm >> 7, ks = (u.pm >> 5) & 3;
        return (const char*)g.Bt + (size_t)ten * (1u << 20) + (size_t)ks * 512 * 2; }
};

__device__ __forceinline__ float gelu_tanh(float v) {
    const float e = __builtin_amdgcn_exp2f(-2.302208198f * v * (1.0f + 0.044715f * v * v));
    return v * __builtin_amdgcn_rcpf(1.0f + e);
}
template <int ACT> struct EpiAct {
    static constexpr bool PERM = true, AFTER_DRAIN = false, HAS_MID = false;
    bf16_t* O; int ldc; const float* bias; const float* rowscale;
    __device__ __forceinline__ void operator()(const f32x4 (&acc)[2][2][4][2], const Unit& u, int wr, int wc, int fr, int fq) const {
        const int row0 = u.pm * BM + wr * 64 + fr; const int col0 = u.pn * BM + wc * 32 + 8 * fq;
        f32x4 bv[2][2];
#pragma unroll
        for (int bj = 0; bj < 2; ++bj)
#pragma unroll
            for (int n = 0; n < 2; ++n) bv[bj][n] = bias ? *(const f32x4*)(bias + col0 + bj * HALF + 4 * n) : (f32x4){0.f, 0.f, 0.f, 0.f};
#pragma unroll
        for (int ai = 0; ai < 2; ++ai)
#pragma unroll
            for (int m = 0; m < 4; ++m) { bf16_t* rowp = O + (size_t)(row0 + ai * HALF + m * 16) * ldc + col0; const float rsc = rowscale ? rowscale[row0 + ai * HALF + m * 16] : 1.0f;
#pragma unroll
                for (int bj = 0; bj < 2; ++bj) { f32x4 v0 = acc[ai][bj][m][0] * rsc + bv[bj][0], v1 = acc[ai][bj][m][1] * rsc + bv[bj][1];
                    if (ACT == 2) {
#pragma unroll
                        for (int e = 0; e < 4; ++e) { v0[e] = gelu_tanh(v0[e]); v1[e] = gelu_tanh(v1[e]); } }
                    if (ACT == 3) {
#pragma unroll
                        for (int e = 0; e < 4; ++e) { const float a = fmaxf(v0[e], 0.f), b = fmaxf(v1[e], 0.f); v0[e] = a * a; v1[e] = b * b; } }
                    u32x4 w; w.x = cvt_pk_bf16(v0[0], v0[1]); w.y = cvt_pk_bf16(v0[2], v0[3]); w.z = cvt_pk_bf16(v1[0], v1[1]); w.w = cvt_pk_bf16(v1[2], v1[3]);
                    *(u32x4*)(rowp + bj * HALF) = w; } }
    }
};
struct EpiSsq {
    static constexpr bool PERM = true, AFTER_DRAIN = false, HAS_MID = false;
    bf16_t* O; int ldc; float* ssq;
    __device__ __forceinline__ void operator()(const f32x4 (&acc)[2][2][4][2], const Unit& u, int wr, int wc, int fr, int fq) const {
        const int row0 = u.pm * BM + wr * 64 + fr; const int col0 = u.pn * BM + wc * 32 + 8 * fq;
#pragma unroll
        for (int ai = 0; ai < 2; ++ai)
#pragma unroll
            for (int m = 0; m < 4; ++m) { const int row = row0 + ai * HALF + m * 16; bf16_t* rowp = O + (size_t)row * ldc + col0; float s = 0.f;
#pragma unroll
                for (int bj = 0; bj < 2; ++bj) { const f32x4 v0 = acc[ai][bj][m][0], v1 = acc[ai][bj][m][1];
                    s += (v0[0] * v0[0] + v0[1] * v0[1]) + (v0[2] * v0[2] + v0[3] * v0[3]); s += (v1[0] * v1[0] + v1[1] * v1[1]) + (v1[2] * v1[2] + v1[3] * v1[3]);
                    u32x4 w; w.x = cvt_pk_bf16(v0[0], v0[1]); w.y = cvt_pk_bf16(v0[2], v0[3]); w.z = cvt_pk_bf16(v1[0], v1[1]); w.w = cvt_pk_bf16(v1[2], v1[3]);
                    *(u32x4*)(rowp + bj * HALF) = w; }
                s += __shfl_xor(s, 16); s += __shfl_xor(s, 32);
                if (fq == 0) ssq[(size_t)row * 32 + u.pn * 4 + wc] = s; }
    }
};
struct EpiGate {
    static constexpr bool PERM = true, AFTER_DRAIN = false, HAS_MID = false;
    float* out; const bf16_t* h2; const bf16_t* pp; int ldc;
    __device__ __forceinline__ void operator()(const f32x4 (&acc)[2][2][4][2], const Unit& u, int wr, int wc, int fr, int fq) const {
        const int row0 = u.pm * BM + wr * 64 + fr; const int col0 = u.pn * BM + wc * 32 + 8 * fq;
#pragma unroll
        for (int ai = 0; ai < 2; ++ai)
#pragma unroll
            for (int m = 0; m < 4; ++m) { const size_t ro = (size_t)(row0 + ai * HALF + m * 16) * ldc + col0;
#pragma unroll
                for (int bj = 0; bj < 2; ++bj) { const f32x4 v0 = acc[ai][bj][m][0], v1 = acc[ai][bj][m][1];
                    const u32x4 pw = *(const u32x4*)(pp + ro + bj * HALF), hw = *(const u32x4*)(h2 + ro + bj * HALF); float* op = out + ro + bj * HALF;
                    const unsigned pu[4] = {pw.x, pw.y, pw.z, pw.w}, hu[4] = {hw.x, hw.y, hw.z, hw.w};
                    f32x4 h0, h1;
#pragma unroll
                    for (int e = 0; e < 4; ++e) { h0[e] = __uint_as_float((e & 1) ? (hu[e >> 1] & 0xffff0000u) : (hu[e >> 1] << 16)); h1[e] = __uint_as_float((e & 1) ? (hu[2 + (e >> 1)] & 0xffff0000u) : (hu[2 + (e >> 1)] << 16)); }
#pragma unroll
                    for (int e = 0; e < 4; ++e) { const float p0 = __uint_as_float((e & 1) ? (pu[e >> 1] & 0xffff0000u) : (pu[e >> 1] << 16));
                        const float p1 = __uint_as_float((e & 1) ? (pu[2 + (e >> 1)] & 0xffff0000u) : (pu[2 + (e >> 1)] << 16));
                        h0[e] += __builtin_amdgcn_rcpf(1.0f + __builtin_amdgcn_exp2f(-LOG2E * v0[e])) * p0;
                        h1[e] += __builtin_amdgcn_rcpf(1.0f + __builtin_amdgcn_exp2f(-LOG2E * v1[e])) * p1; }
                    *(f32x4*)op = h0; *(f32x4*)(op + 4) = h1; } }
    }
};
struct EpiSsqY {
    static constexpr bool PERM = true, AFTER_DRAIN = false, HAS_MID = true;
    bf16_t* O; int ldc; float* ssq; const PG8_LAS float* tab;
    __device__ __forceinline__ void mid(f32x4 (&acc)[2][2][4][2], int ui, int wr, int fr) const {
#pragma unroll
        for (int ai = 0; ai < 2; ++ai)
#pragma unroll
            for (int m = 0; m < 4; ++m) { const float rt = tab[(ui * 256 + ai * HALF + wr * 64 + m * 16 + fr) * 2];
#pragma unroll
                for (int bj = 0; bj < 2; ++bj) { acc[ai][bj][m][0] *= rt; acc[ai][bj][m][1] *= rt; } }
    }
    __device__ __forceinline__ void fin(const f32x4 (&acc)[2][2][4][2], const Unit& u, int ui, int wr, int wc, int fr, int fq) const {
        const int row0 = u.pm * BM + wr * 64 + fr; const int col0 = u.pn * BM + wc * 32 + 8 * fq;
#pragma unroll
        for (int ai = 0; ai < 2; ++ai)
#pragma unroll
            for (int m = 0; m < 4; ++m) { const int row = row0 + ai * HALF + m * 16; bf16_t* rowp = O + (size_t)row * ldc + col0; float s = 0.f;
                const float rn = tab[(ui * 256 + ai * HALF + wr * 64 + m * 16 + fr) * 2 + 1];
#pragma unroll
                for (int bj = 0; bj < 2; ++bj) { const f32x4 v0 = acc[ai][bj][m][0] * rn, v1 = acc[ai][bj][m][1] * rn;
                    s += (v0[0] * v0[0] + v0[1] * v0[1]) + (v0[2] * v0[2] + v0[3] * v0[3]); s += (v1[0] * v1[0] + v1[1] * v1[1]) + (v1[2] * v1[2] + v1[3] * v1[3]);
                    u32x4 w; w.x = cvt_pk_bf16(v0[0], v0[1]); w.y = cvt_pk_bf16(v0[2], v0[3]); w.z = cvt_pk_bf16(v1[0], v1[1]); w.w = cvt_pk_bf16(v1[2], v1[3]);
                    *(u32x4*)(rowp + bj * HALF) = w; }
                s += __shfl_xor(s, 16); s += __shfl_xor(s, 32);
                if (fq == 0) ssq[(size_t)row * 32 + u.pn * 4 + wc] = s; }
    }
};
template <class Epi, class Sched, class AM, bool ALIGN_EPI = false, bool SP2 = false>
__device__ __forceinline__ void gemm_phase(PG8_LAS unsigned char* lds, const Gemm g, const Sched& S, const Epi& E) {
    const int tid = threadIdx.x, wid = __builtin_amdgcn_readfirstlane(tid >> 6), lane = tid & 63, wr = wid >> 2, wc = wid & 3, fr = lane & 15, fq = lane >> 4;
    const int K = g.K, nt = K / BK;
    unsigned voffA[2], voffB[2];
#pragma unroll
    for (int i = 0; i < 2; ++i) { int R, C; stage_rc(tid * 16 + i * 8192, R, C); const int Rb = Epi::PERM ? ((R & ~31) + perm32(R & 31)) : R;
        voffA[i] = (unsigned)(R * AM::lda(g) + C) * 2u; voffB[i] = (unsigned)(Rb * AM::ldb(g) + C) * 2u; }
    const size_t kstep = (size_t)(BK * 2); const size_t kstepA = AM::kstep(g), hstepA = AM::hstep(g);
    const size_t hstep = (size_t)HALF * AM::ldb(g) * 2;
    const size_t tstep = 2 * hstep;
    const unsigned ldsw = (unsigned)wid * 1024u;
    const int aoff = lds_byte(wr * 64 + fr, fq * 8), boff = lds_byte(wc * 32 + fr, fq * 8);
#define PG8_SA(b, h) (((b) * 2 + (h)) * HTB)
#define PG8_SB(b, h) ((4 + (b) * 2 + (h)) * HTB)
#define PG8_STAGE(bufoff, gbase, voff) do { _Pragma("unroll") for (int _i = 0; _i < 2; ++_i) \
        __builtin_amdgcn_global_load_lds((const unsigned*)((const char*)(gbase) + (voff)[_i]), (PG8_LAS unsigned*)(lds + (bufoff) + ldsw + _i * 8192), 16, 0, 0); } while (0)
#define PG8_LDA(dst, b, h) do { _Pragma("unroll") for (int m = 0; m < 4; ++m) _Pragma("unroll") for (int k = 0; k < 2; ++k) dst[m][k] = *(const PG8_LAS bf16x8*)(lds + PG8_SA(b, h) + aoff + m * 2048 + k * 1024); } while (0)
#define PG8_LDB(dst, b, h) do { _Pragma("unroll") for (int n = 0; n < 2; ++n) _Pragma("unroll") for (int k = 0; k < 2; ++k) dst[n][k] = *(const PG8_LAS bf16x8*)(lds + PG8_SB(b, h) + boff + n * 2048 + k * 1024); } while (0)
#define PG8_MMA(ai, bj, At, Bt) do { __builtin_amdgcn_s_setprio(1); _Pragma("unroll") for (int m = 0; m < 4; ++m) _Pragma("unroll") for (int n = 0; n < 2; ++n) _Pragma("unroll") for (int k = 0; k < 2; ++k) \
        acc[ai][bj][m][n] = __builtin_amdgcn_mfma_f32_16x16x32_bf16(Bt[n][k], At[m][k], acc[ai][bj][m][n], 0, 0, 0); __builtin_amdgcn_s_setprio(0); } while (0)
#define PG8_WAIT_V(n) asm volatile("s_waitcnt vmcnt(" #n ")" ::: "memory")
#define PG8_WAIT_L(n) asm volatile("s_waitcnt lgkmcnt(" #n ")" ::: "memory")
#define PG8_BAR __builtin_amdgcn_s_barrier()
#define PG8_SCHED __builtin_amdgcn_sched_barrier(0)
    Unit cur, nxt; int ui = 0;
    if (!S.next(0, cur)) return;
    f32x4 acc[2][2][4][2];
#pragma unroll
    for (int a = 0; a < 2; ++a)
#pragma unroll
        for (int b = 0; b < 2; ++b)
#pragma unroll
            for (int m = 0; m < 4; ++m)
#pragma unroll
                for (int n = 0; n < 2; ++n) acc[a][b][m][n] = (f32x4){0.f, 0.f, 0.f, 0.f};
    bf16x8 At[4][2], B0[2][2], B1[2][2];
    const char* cA = AM::base(g, cur); const char* cB = AM::baseB(g, cur);
    S.a_ready(cur);
    if constexpr (SP2) {
        PG8_STAGE(PG8_SB(0, 0), cB, voffB); PG8_STAGE(PG8_SB(0, 1), cB + hstep, voffB); PG8_STAGE(PG8_SA(0, 0), cA, voffA); PG8_STAGE(PG8_SA(0, 1), cA + hstepA, voffA);
        if (wr == 1) PG8_BAR;
        PG8_WAIT_V(2); PG8_BAR;
        PG8_STAGE(PG8_SB(1, 0), cB + kstep, voffB); PG8_STAGE(PG8_SA(1, 0), cA + kstepA, voffA); PG8_STAGE(PG8_SB(1, 1), cB + hstep + kstep, voffB);
        PG8_WAIT_V(6); PG8_BAR;
    } else {
        PG8_STAGE(PG8_SB(0, 0), cB, voffB); PG8_STAGE(PG8_SA(0, 0), cA, voffA); PG8_STAGE(PG8_SB(0, 1), cB + hstep, voffB); PG8_STAGE(PG8_SA(0, 1), cA + hstepA, voffA);
        if (wr == 1) PG8_BAR;
        PG8_WAIT_V(4); PG8_BAR;
        PG8_STAGE(PG8_SB(1, 0), cB + kstep, voffB); PG8_STAGE(PG8_SA(1, 0), cA + kstepA, voffA); PG8_STAGE(PG8_SB(1, 1), cB + hstep + kstep, voffB);
        PG8_WAIT_V(6); PG8_BAR;
    }
    for (;;) {
        const bool has_next = S.next(ui + 1, nxt);
        const char* nA = has_next ? AM::base(g, nxt) : cA; const char* nB = has_next ? AM::baseB(g, nxt) : cB;
        for (int t = 0; t < nt; t += 2) {
            const bool last = (t == nt - 2);
            const char* a1 = cA + (size_t)(t + 1) * kstepA;
            const char* a2 = last ? nA : cA + (size_t)(t + 2) * kstepA; const char* b2 = last ? nB : cB + (size_t)(t + 2) * kstep;
            const char* a3 = a2 + kstepA; const char* b3 = b2 + kstep;
            if (last && has_next) S.a_ready(nxt);
            if constexpr (Epi::HAS_MID) { if (t == nt / 2) E.mid(acc, ui, wr, fr); }
            if constexpr (SP2) {
            PG8_LDB(B0, 0, 0); PG8_LDB(B1, 0, 1); PG8_SCHED; PG8_LDA(At, 0, 0); PG8_STAGE(PG8_SA(1, 1), a1 + hstepA, voffA);
            PG8_WAIT_V(8); PG8_WAIT_L(0); PG8_BAR; PG8_MMA(0, 0, At, B0); PG8_MMA(0, 1, At, B1); PG8_BAR; PG8_SCHED;
            PG8_LDA(At, 0, 1); PG8_STAGE(PG8_SB(0, 0), b2, voffB); PG8_STAGE(PG8_SB(0, 1), b2 + hstep, voffB); PG8_STAGE(PG8_SA(0, 0), a2, voffA);
            PG8_WAIT_V(8); PG8_WAIT_L(0); PG8_BAR; PG8_MMA(1, 0, At, B0); PG8_MMA(1, 1, At, B1); PG8_BAR; PG8_SCHED;
            PG8_LDB(B0, 1, 0); PG8_LDB(B1, 1, 1); PG8_SCHED; PG8_LDA(At, 1, 0); PG8_STAGE(PG8_SA(0, 1), a2 + hstepA, voffA);
            PG8_WAIT_V(8); PG8_WAIT_L(0); PG8_BAR; PG8_MMA(0, 0, At, B0); PG8_MMA(0, 1, At, B1); PG8_BAR; PG8_SCHED;
            PG8_LDA(At, 1, 1); PG8_STAGE(PG8_SB(1, 0), b3, voffB); PG8_STAGE(PG8_SB(1, 1), b3 + hstep, voffB); PG8_STAGE(PG8_SA(1, 0), a3, voffA);
            PG8_WAIT_V(8); PG8_WAIT_L(0); PG8_BAR; PG8_MMA(1, 0, At, B0); PG8_MMA(1, 1, At, B1); PG8_BAR; PG8_SCHED;
            } else {
            PG8_LDB(B0, 0, 0); PG8_SCHED; PG8_LDA(At, 0, 0); PG8_STAGE(PG8_SA(1, 1), a1 + hstepA, voffA);
            PG8_WAIT_L(8); PG8_BAR; PG8_WAIT_L(0); PG8_MMA(0, 0, At, B0); PG8_BAR; PG8_SCHED;
            PG8_LDB(B1, 0, 1); PG8_STAGE(PG8_SB(0, 0), b2, voffB);
            PG8_BAR; PG8_WAIT_L(0); PG8_MMA(0, 1, At, B1); PG8_BAR;
            PG8_LDA(At, 0, 1); PG8_STAGE(PG8_SA(0, 0), a2, voffA);
            PG8_BAR; PG8_WAIT_L(0); PG8_MMA(1, 0, At, B0); PG8_BAR; PG8_SCHED;
            PG8_STAGE(PG8_SB(0, 1), b2 + hstep, voffB);
            PG8_WAIT_V(6); PG8_BAR; PG8_MMA(1, 1, At, B1); PG8_BAR;
            PG8_LDB(B0, 1, 0); PG8_SCHED; PG8_LDA(At, 1, 0); PG8_STAGE(PG8_SA(0, 1), a2 + hstepA, voffA);
            PG8_WAIT_L(8); PG8_BAR; PG8_WAIT_L(0); PG8_MMA(0, 0, At, B0); PG8_BAR; PG8_SCHED;
            PG8_LDB(B1, 1, 1); PG8_STAGE(PG8_SB(1, 0), b3, voffB);
            PG8_BAR; PG8_WAIT_L(0); PG8_MMA(0, 1, At, B1); PG8_BAR;
            PG8_LDA(At, 1, 1); PG8_STAGE(PG8_SA(1, 0), a3, voffA);
            PG8_BAR; PG8_WAIT_L(0); PG8_MMA(1, 0, At, B0); PG8_BAR; PG8_SCHED;
            PG8_STAGE(PG8_SB(1, 1), b3 + hstep, voffB);
            PG8_WAIT_V(6); PG8_BAR; PG8_MMA(1, 1, At, B1); PG8_BAR;
            }
        }
        if constexpr (ALIGN_EPI) { if (wr == 0) PG8_BAR; }
        if constexpr (!Epi::AFTER_DRAIN) { if constexpr (Epi::HAS_MID) E.fin(acc, cur, ui, wr, wc, fr, fq); else E(acc, cur, wr, wc, fr, fq); S.done(cur); }
        if (!has_next) break;
#pragma unroll
        for (int a = 0; a < 2; ++a)
#pragma unroll
            for (int b = 0; b < 2; ++b)
#pragma unroll
                for (int m = 0; m < 4; ++m)
#pragma unroll
                    for (int n = 0; n < 2; ++n) acc[a][b][m][n] = (f32x4){0.f, 0.f, 0.f, 0.f};
        cur = nxt; cA = nA; cB = nB; ++ui;
        if constexpr (ALIGN_EPI) { if (wr == 1) PG8_BAR; }
    }
    PG8_WAIT_V(0);
    if constexpr (!ALIGN_EPI) { if (wr == 0) PG8_BAR; }
    PG8_BAR;
    if constexpr (Epi::AFTER_DRAIN) { E.fused(acc, cur, wr, wc, fr, fq, lds, wid, lane); S.done(cur); }
#undef PG8_SA
#undef PG8_SB
#undef PG8_STAGE
#undef PG8_LDA
#undef PG8_LDB
#undef PG8_MMA
#undef PG8_WAIT_V
#undef PG8_WAIT_L
#undef PG8_BAR
#undef PG8_SCHED
}
}
constexpr size_t MiB = 1u << 20;
constexpr size_t WS_CTL = 0, CTL_ZERO_BYTES = 1 * MiB;
constexpr size_t WS_WIN = 2 * MiB, WS_WOUT = 21 * MiB, WS_W1 = 29 * MiB, WS_W2 = 61 * MiB, WS_WG = 93 * MiB, WS_WP = 101 * MiB, WS_CW1K = 102 * MiB, WS_CW1V = 103 * MiB;
constexpr size_t WS_MISC = 104 * MiB;
constexpr size_t WS_PB = 105 * MiB;
constexpr size_t WS_HID = 121 * MiB;
constexpr size_t WS_KCVC = 129 * MiB;
constexpr size_t WS_SSL = 131 * MiB, WS_SSN = 133 * MiB;
constexpr size_t WS_SSQ = 134 * MiB;
constexpr size_t WS_A = 140 * MiB;
constexpr size_t WS_Z = 268 * MiB;
constexpr size_t WS_Y = 573 * MiB;
constexpr size_t WS_T = 701 * MiB;
constexpr size_t WS_HID2 = 268 * MiB;
constexpr size_t WS_F = 780 * MiB;
constexpr size_t WS_PP = 268 * MiB;
constexpr size_t WS_HIDP = 908 * MiB;
constexpr size_t WS_END = 940 * MiB;
constexpr int CW_TMO = 0, CW_CODE = 1, CW_BAR = 4096;

constexpr int RING_OFF = 0, RING_BYTES = 131072;
constexpr int LDSCTL_OFF = RING_BYTES, MISC_OFF = LDSCTL_OFF + 320;
constexpr int LDS_BYTES = 147456;
constexpr int NWAVES = 8;

#define GAS __attribute__((address_space(1)))
#define LAS __attribute__((address_space(3)))
typedef unsigned short bf16;
typedef unsigned v4u __attribute__((ext_vector_type(4)));
typedef unsigned v2u __attribute__((ext_vector_type(2)));
typedef float f32x4 __attribute__((ext_vector_type(4)));
typedef float f32x16 __attribute__((ext_vector_type(16)));
typedef short bf16x8 __attribute__((ext_vector_type(8)));
typedef short s16x4 __attribute__((ext_vector_type(4)));
typedef GAS unsigned gu32;
#define RLX_AGENT __ATOMIC_RELAXED, __HIP_MEMORY_SCOPE_AGENT
#define LDS_WAIT() asm volatile("s_waitcnt lgkmcnt(0)" ::: "memory")
#define VM_WAIT() asm volatile("s_waitcnt vmcnt(0)" ::: "memory")
__device__ __forceinline__ unsigned f2bf(float f) { unsigned u = __builtin_bit_cast(unsigned, f); return (u + 0x7fffu + ((u >> 16) & 1u)) >> 16; }
__device__ __forceinline__ unsigned pk2(float lo, float hi) { return f2bf(lo) | (f2bf(hi) << 16); }
__device__ __forceinline__ float bf2f(unsigned b) { return __uint_as_float(b << 16); }
__device__ __forceinline__ float bflo(unsigned w) { return __uint_as_float(w << 16); }
__device__ __forceinline__ float bfhi(unsigned w) { return __uint_as_float(w & 0xffff0000u); }
__device__ __forceinline__ float wave_sum(float v) {
#pragma unroll
    for (int o = 1; o < 64; o <<= 1) v += __shfl_xor(v, o);
    return v;
}
__device__ __forceinline__ float sigmoidf_(float v) { return __builtin_amdgcn_rcpf(1.0f + __builtin_amdgcn_exp2f(-LOG2E * v)); }
#define XB_TMO      128
#define XB_XCNT(j)  (256  + 64 * (j))
#define XB_XSUB(j)  (1280 + 64 * (j))
#define XB_XGEN(j)  (2304 + 64 * (j))
#define XB_TOP      3328
#define XB_TOPGEN   3392
#define XCD_BAR_WORDS 3456
#define XB_SPIN_CAP (1u << 18)

__device__ __forceinline__ unsigned xb_ld(unsigned* p)              { return __hip_atomic_load(p, __ATOMIC_RELAXED, __HIP_MEMORY_SCOPE_AGENT); }
__device__ __forceinline__ unsigned xb_add(unsigned* p, unsigned v) { return __hip_atomic_fetch_add(p, v, __ATOMIC_RELAXED, __HIP_MEMORY_SCOPE_AGENT); }
__device__ __forceinline__ unsigned xb_xcc_id() { return (unsigned)__builtin_amdgcn_s_getreg((3 << 11) | 20) & 0xFu; }
#define XB_SPIN(cond, bar) do { unsigned _sp = 0; while (cond) { __builtin_amdgcn_s_sleep(1); \
    if ((++_sp & 255u) == 0u) { if (xb_ld(&(bar)[XB_TMO])) break; if (_sp > XB_SPIN_CAP) { atomicAdd(&(bar)[XB_TMO], 1u); break; } } } } while (0)

struct XcdBarrier {
    unsigned* bar; unsigned x;
    volatile LAS unsigned* st;
};

__device__ __forceinline__ XcdBarrier xcd_barrier_post(unsigned* bar, volatile LAS unsigned* st) {
    XcdBarrier b; b.bar = bar; b.x = xb_xcc_id(); b.st = st;
    if (threadIdx.x == 0) (void)xb_add(&bar[XB_XCNT(b.x)], 1u);
    return b;
}
__device__ __forceinline__ void xcd_barrier_complete(unsigned* bar, unsigned x, unsigned& nloc, unsigned& nx) {
    const unsigned G = gridDim.x * gridDim.y * gridDim.z;
    unsigned sum, cnt, mine, sp = 0u;
    for (;;) {
        sum = 0u; cnt = 0u; mine = 0u;
#pragma unroll
        for (unsigned j = 0; j < 16; ++j) { const unsigned c = xb_ld(&bar[XB_XCNT(j)]); sum += c; cnt += (c > 0u) ? 1u : 0u; mine = (j == x) ? c : mine; }
        if (sum == G) break;
        __builtin_amdgcn_s_sleep(1);
        if ((++sp & 255u) == 0u) { if (xb_ld(&bar[XB_TMO])) break; if (sp > XB_SPIN_CAP) { atomicAdd(&bar[XB_TMO], 1u); break; } }
    }
    nloc = mine > 0u ? mine : 1u; nx = cnt > 0u ? cnt : 1u;
}

__device__ __forceinline__ void xcd_barrier(const XcdBarrier& b) {
    asm volatile("s_waitcnt vmcnt(0)" ::: "memory");
    __syncthreads();
    if (threadIdx.x == 0) {
        unsigned* bar = b.bar;
        __builtin_amdgcn_s_waitcnt(0);
        unsigned nloc = b.st[0], nx = b.st[1];
        if (nloc == 0u) { xcd_barrier_complete(bar, b.x, nloc, nx); b.st[0] = nloc; b.st[1] = nx; }
        const unsigned old = xb_add(&bar[XB_XSUB(b.x)], 1u);
        const unsigned gen = old / nloc;
        if (old + 1u == (gen + 1u) * nloc) {
            __builtin_amdgcn_fence(__ATOMIC_RELEASE, "agent");
            asm volatile("s_waitcnt vmcnt(0)" ::: "memory");
            const unsigned og = xb_add(&bar[XB_TOP], 1u);
            const unsigned tg = og / nx;
            if (og + 1u == (tg + 1u) * nx) xb_add(&bar[XB_TOPGEN], 1u);
            else XB_SPIN(xb_ld(&bar[XB_TOPGEN]) == tg, bar);
            __builtin_amdgcn_fence(__ATOMIC_ACQUIRE, "agent");
            xb_add(&bar[XB_XGEN(b.x)], 1u);
            asm volatile("s_waitcnt vmcnt(0)" ::: "memory");
        } else {
            XB_SPIN(xb_ld(&bar[XB_XGEN(b.x)]) == gen, bar);
            __builtin_amdgcn_fence(__ATOMIC_ACQUIRE, "agent");
            asm volatile("s_waitcnt vmcnt(0)" ::: "memory");
        }
    }
    __syncthreads();
}

namespace nsa {
constexpr int KPB = 144, VPB = 160;
constexpr int KBUF = 64 * KPB, VBUF = 64 * VPB;
constexpr int NBUF = 3, L_K = 0, L_V = NBUF * KBUF, L_BIAS = L_V + NBUF * VBUF, L_PSUM = L_BIAS + 2048, L_IMPV = L_PSUM + 128 * 65 * 4, L_SEL = L_IMPV + 64 * 32 * 4, L_STASH = L_PSUM  , L_SSQ = L_STASH + 65536, L_END = L_SSQ + 1024;
static_assert(L_SEL + 256 <= L_SSQ, "nsa LDS overlay");
static_assert(L_END <= RING_BYTES, "nsa LDS");
constexpr float NEG = -1.0e30f;
constexpr float C1 = 0.125f * LOG2E;
__device__ __forceinline__ int crow(int i, int hh) { return (i & 3) + 8 * (i >> 2) + 4 * hh; }
__device__ __forceinline__ int t5_bucket(int n) {
    if (n < 16) return n;
    int b = 16;
    b += (n >= 19); b += (n >= 21); b += (n >= 24); b += (n >= 27); b += (n >= 31); b += (n >= 35); b += (n >= 40); b += (n >= 46);
    b += (n >= 52); b += (n >= 59); b += (n >= 67); b += (n >= 77); b += (n >= 87); b += (n >= 99); b += (n >= 113);
    return b;
}
__device__ __forceinline__ s16x4 trr(const LAS char* p) { return __builtin_bit_cast(s16x4, __builtin_amdgcn_ds_read_tr16_b64_v4i16((LAS s16x4*)p)); }
__device__ __forceinline__ unsigned cvtpk(float lo, float hi) { typedef float f2 __attribute__((ext_vector_type(2))); typedef __bf16 b2 __attribute__((ext_vector_type(2))); f2 v = {lo, hi}; b2 r = __builtin_convertvector(v, b2); return __builtin_bit_cast(unsigned, r); }
#define NSA_MFMA(a, b, c) __builtin_amdgcn_mfma_f32_32x32x16_bf16((a), (b), (c), 0, 0, 0)

__device__ __forceinline__ void qk_tile(f32x16& s0, f32x16& s1, const LAS char* kbuf, const bf16x8 (&qf)[4], int r32, int hh) {
    const LAS char* kb = kbuf + r32 * KPB + hh * 16;
    const f32x16 z = {0.f,0.f,0.f,0.f,0.f,0.f,0.f,0.f,0.f,0.f,0.f,0.f,0.f,0.f,0.f,0.f};
    { const bf16x8 a0 = *(const LAS bf16x8*)(kb), a1 = *(const LAS bf16x8*)(kb + 32 * KPB);
      s0 = NSA_MFMA(a0, qf[0], z); s1 = NSA_MFMA(a1, qf[0], z); }
#pragma unroll
    for (int d0 = 1; d0 < 4; ++d0) {
        const bf16x8 a0 = *(const LAS bf16x8*)(kb + d0 * 32), a1 = *(const LAS bf16x8*)(kb + 32 * KPB + d0 * 32);
        s0 = NSA_MFMA(a0, qf[d0], s0); s1 = NSA_MFMA(a1, qf[d0], s1);
    }
}
__device__ __forceinline__ void pv_tile(f32x16 (&o)[2], const LAS char* vbuf, const f32x16& p0, const f32x16& p1, int lane) {
    const int hh = lane >> 5, q4 = (lane & 15) >> 2, pp = lane & 3, blk = (lane >> 4) & 1;
    const LAS char* vb = vbuf + (4 * hh + q4) * VPB + blk * 32 + pp * 8;
#define NSA_PK(P, B) ({ v4u w_; w_.x = cvtpk(P[B], P[B + 1]); w_.y = cvtpk(P[B + 2], P[B + 3]); w_.z = cvtpk(P[B + 4], P[B + 5]); w_.w = cvtpk(P[B + 6], P[B + 7]); __builtin_bit_cast(bf16x8, w_); })
#pragma unroll
    for (int s = 0; s < 4; ++s) {
        const bf16x8 pf = (s == 0) ? NSA_PK(p0, 0) : (s == 1) ? NSA_PK(p0, 8) : (s == 2) ? NSA_PK(p1, 0) : NSA_PK(p1, 8);
#pragma unroll
        for (int db = 0; db < 2; ++db) {
            const s16x4 lo = trr(vb + (16 * s) * VPB + db * 64), hi = trr(vb + (16 * s + 8) * VPB + db * 64);
            const bf16x8 vf = {lo[0], lo[1], lo[2], lo[3], hi[0], hi[1], hi[2], hi[3]};
            o[db] = NSA_MFMA(vf, pf, o[db]);
        }
        __builtin_amdgcn_sched_barrier(0);
    }
#undef NSA_PK
}
template <int KS> __device__ __forceinline__ void gen_fix(f32x16& s0, f32x16& s1, int dq, int hi_excl, bool rowok, float off, const LAS float* biasr, int hh) {
    const int dbase = dq - 4 * hh * KS;
    { float bb[16];
#pragma unroll
      for (int i = 0; i < 16; ++i) { const int d0 = dbase - ((i & 3) + 8 * (i >> 2)) * KS; bb[i] = biasr[min(max(d0, 0), 127)]; }
      __builtin_amdgcn_sched_barrier(0);
#pragma unroll
      for (int i = 0; i < 16; ++i) { const int d0 = dbase - ((i & 3) + 8 * (i >> 2)) * KS; const bool v0 = rowok && d0 >= 0 && d0 < hi_excl; s0[i] = v0 ? s0[i] + (bb[i] + off) : NEG; } }
    __builtin_amdgcn_sched_barrier(0);
    { float bb[16];
#pragma unroll
      for (int i = 0; i < 16; ++i) { const int d1 = dbase - ((i & 3) + 8 * (i >> 2) + 32) * KS; bb[i] = biasr[min(max(d1, 0), 127)]; }
      __builtin_amdgcn_sched_barrier(0);
#pragma unroll
      for (int i = 0; i < 16; ++i) { const int d1 = dbase - ((i & 3) + 8 * (i >> 2) + 32) * KS; const bool v1 = rowok && d1 >= 0 && d1 < hi_excl; s1[i] = v1 ? s1[i] + (bb[i] + off) : NEG; } }
}
__device__ __forceinline__ float max3f(float a, float b, float c) { float r; asm("v_max3_f32 %0, %1, %2, %3" : "=v"(r) : "v"(a), "v"(b), "v"(c)); return r; }
__device__ __forceinline__ float max32(const f32x16& a, const f32x16& b) {
    float x = max3f(a[0], a[1], a[2]), y = max3f(b[0], b[1], b[2]);
    x = max3f(x, a[3], a[4]); y = max3f(y, b[3], b[4]); x = max3f(x, a[5], a[6]); y = max3f(y, b[5], b[6]);
    x = max3f(x, a[7], a[8]); y = max3f(y, b[7], b[8]); x = max3f(x, a[9], a[10]); y = max3f(y, b[9], b[10]);
    x = max3f(x, a[11], a[12]); y = max3f(y, b[11], b[12]); x = max3f(x, a[13], a[14]); y = max3f(y, b[13], b[14]);
    return max3f(x, y, fmaxf(a[15], b[15]));
}
template <int KS, bool GEN> __device__ __forceinline__ void tile_soft(f32x16& s0, f32x16& s1, const LAS char* vbuf, float& negm, f32x16 (&o)[2], float& lacc,
                                                                       bool first, bool rowok, float bfar, int dq, int hi_excl, const LAS float* biasr, int lane);
template <int KS, bool GEN> __device__ __forceinline__ void tile_step(const LAS char* kbuf, const LAS char* vbuf, const bf16x8 (&qf)[4], float& negm, f32x16 (&o)[2], float& lacc,
                                                                       bool first, bool rowok, float bfar, int dq, int hi_excl, const LAS float* biasr, int lane) {
    const int r32 = lane & 31, hh = lane >> 5;
    f32x16 s0, s1;
    qk_tile(s0, s1, kbuf, qf, r32, hh);
    tile_soft<KS, GEN>(s0, s1, vbuf, negm, o, lacc, first, rowok, bfar, dq, hi_excl, biasr, lane);
}
template <int KS, bool GEN> __device__ __forceinline__ void tile_soft(f32x16& s0, f32x16& s1, const LAS char* vbuf, float& negm, f32x16 (&o)[2], float& lacc,
                                                                       bool first, bool rowok, float bfar, int dq, int hi_excl, const LAS float* biasr, int lane) {
    const int hh = lane >> 5;
    constexpr float THR = 8.0f;
    float cv = rowok ? bfar + negm : NEG;
    if (GEN) { gen_fix<KS>(s0, s1, dq, hi_excl, rowok, negm, biasr, hh); cv = 0.f; }
    float rm = max32(s0, s1) + cv; rm = fmaxf(rm, __shfl_xor(rm, 32));
    const bool need = first ? (rm > -1.0e29f) : (rm > THR);
    if (__any(need)) {
        const float dl = need ? rm : 0.f, alpha = __builtin_amdgcn_exp2f(-dl);
        negm -= dl; cv -= dl;
#pragma unroll
        for (int i = 0; i < 16; ++i) { o[0][i] *= alpha; o[1][i] *= alpha; }
        lacc *= alpha;
    }
    float ps = 0.f;
#pragma unroll
    for (int i = 0; i < 16; ++i) { s0[i] = __builtin_amdgcn_exp2f(s0[i] + cv); s1[i] = __builtin_amdgcn_exp2f(s1[i] + cv); ps += s0[i] + s1[i]; }
    lacc += ps;
    pv_tile(o, vbuf, s0, s1, lane);
}

struct Tens { const bf16* z; const bf16* kcvc; const float* relb; bf16* y; float* ssn; };

__device__ __forceinline__ void branches(LAS char* lds, const Tens& T, int b, int g, int qt, int tq, const bf16x8 (&qf)[4], const LAS float* biasr, float bfar,
                                         unsigned selmask, float g_s, float g_w, LAS char* stash, int tid, int lane) {
    const int skey = tid >> 3, sch = tid & 7;
    const bf16* rowp = T.z + (size_t)(b * SEQ + skey) * ZP + g * 64 + sch * 8;
    const int n1 = qt + 1, lo2 = (qt > 8 ? qt - 8 : 0), total = n1 + (qt - lo2 + 1);
    LAS char* kdst = lds + L_K + skey * KPB + sch * 16; LAS char* vdst = lds + L_V + skey * VPB + sch * 16;
    float negm = 0.f, lacc = 0.f; f32x16 o[2];
#pragma unroll
    for (int i = 0; i < 16; ++i) { o[0][i] = 0.f; o[1][i] = 0.f; }
#define NSA_LOAD(j, kr, vr) do { int jl_ = (j); jl_ = jl_ < total ? jl_ : total - 1; const bool wl_ = jl_ >= n1; const int ktl_ = wl_ ? lo2 + (jl_ - n1) : jl_; \
        const bf16* pl_ = rowp + (size_t)ktl_ * 64 * ZP + (wl_ ? C_KW : C_KS); kr = *(const v4u*)pl_; vr = *(const v4u*)(pl_ + (C_VS - C_KS)); } while (0)
#define NSA_FLUSH(gate_) do { const float sc_ = (gate_) * __builtin_amdgcn_rcpf(lacc + __shfl_xor(lacc, 32)); \
        _Pragma("unroll") for (int db = 0; db < 2; ++db) _Pragma("unroll") for (int i4 = 0; i4 < 4; ++i4) { LAS f32x4* sp = (LAS f32x4*)(stash + (db * 4 + i4) * 1024); f32x4 y = *sp; \
            y.x = fmaf(sc_, o[db][4 * i4], y.x); y.y = fmaf(sc_, o[db][4 * i4 + 1], y.y); y.z = fmaf(sc_, o[db][4 * i4 + 2], y.z); y.w = fmaf(sc_, o[db][4 * i4 + 3], y.w); *sp = y; } } while (0)
#define NSA_BAR() asm volatile("s_waitcnt lgkmcnt(0)\n\ts_barrier" ::: "memory")
    static_assert(C_VS - C_KS == C_VW - C_KW, "K -> V column offset is the same for both branches");
    v4u kr, vr;
    NSA_LOAD(0, kr, vr); *(LAS v4u*)(kdst) = kr; *(LAS v4u*)(vdst) = vr;
    NSA_LOAD(1, kr, vr); *(LAS v4u*)(kdst + KBUF) = kr; *(LAS v4u*)(vdst + VBUF) = vr;
    NSA_BAR();
    int s_cur = 0, s_nxt = 1, s_fill = 2;
    const int r32 = lane & 31, hh = lane >> 5;
    f32x16 sa0, sa1, sb0, sb1;
    qk_tile(sa0, sa1, lds + L_K, qf, r32, hh);
#define NSA_STEP(j, C0, C1, N0, N1) do { const int j_ = (j); \
        if (j_ == n1) { NSA_FLUSH(g_s); negm = 0.f; lacc = 0.f; _Pragma("unroll") for (int i = 0; i < 16; ++i) { o[0][i] = 0.f; o[1][i] = 0.f; } } \
        NSA_LOAD(j_ + 2, kr, vr); \
        if (j_ + 1 < total) qk_tile(N0, N1, lds + L_K + s_nxt * KBUF, qf, r32, hh); \
        __builtin_amdgcn_sched_barrier(0); \
        const bool w_ = j_ >= n1; const int kt_ = w_ ? lo2 + (j_ - n1) : j_; \
        const bool first_ = (j_ == 0) || (j_ == n1); \
        const bool rowok_ = w_ ? true : (((selmask >> kt_) & 1u) != 0u); \
        const bool gen_ = (kt_ >= qt - 2) || (w_ && kt_ == qt - 8); \
        const int dq_ = tq - kt_ * 64; \
        if (gen_) tile_soft<1, true>(C0, C1, lds + L_V + s_cur * VBUF, negm, o, lacc, first_, rowok_, bfar, dq_, w_ ? 512 : 0x7fffffff, biasr, lane); \
        else tile_soft<1, false>(C0, C1, lds + L_V + s_cur * VBUF, negm, o, lacc, first_, rowok_, bfar, dq_, 0, biasr, lane); \
        *(LAS v4u*)(kdst + s_fill * KBUF) = kr; *(LAS v4u*)(vdst + s_fill * VBUF) = vr; \
        NSA_BAR(); \
        const int t_ = s_cur; s_cur = s_nxt; s_nxt = s_fill; s_fill = t_; } while (0)
#pragma unroll 1
    for (int j = 0; j < total; j += 2) {
        NSA_STEP(j, sa0, sa1, sb0, sb1);
        if (j + 1 < total) NSA_STEP(j + 1, sb0, sb1, sa0, sa1);
    }
#undef NSA_STEP
    NSA_FLUSH(g_w);
    __syncthreads();
#undef NSA_LOAD
#undef NSA_FLUSH
#undef NSA_BAR
}

__device__ __forceinline__ void fill_bias(LAS char* lds, const float* relb, int g) {
    int tid = threadIdx.x; asm volatile("" : "+v"(tid));
    const int rr = tid >> 7, d = tid & 127;
    ((LAS float*)(lds + L_BIAS))[tid] = relb[t5_bucket(d) * 16 + g * 4 + rr] * LOG2E;
}
#ifndef PROBE_MODE
#define PROBE_MODE 0
#endif
#define NSA_TSACC ((volatile LAS unsigned long long*)(LDSCTL_OFF + 1024 + 256))
#define NSA_MARK(k) do { if (PROBE_MODE && blockIdx.x == 0 && threadIdx.x == 0) { const unsigned long long t_ = __builtin_amdgcn_s_memrealtime(); NSA_TSACC[k] += t_ - NSA_TSACC[15]; NSA_TSACC[15] = t_; } } while (0)
__device__ __forceinline__ void unit(LAS char* lds, const Tens& T, int b, int g, int qt) {
    if (PROBE_MODE && blockIdx.x == 0 && threadIdx.x == 0) NSA_TSACC[15] = __builtin_amdgcn_s_memrealtime();
    int tid = threadIdx.x; asm volatile("" : "+v"(tid));
    const int lane = tid & 63, wid = __builtin_amdgcn_readfirstlane(tid >> 6);
    const int r = wid >> 1, qh = wid & 1, r32 = lane & 31, hh = lane >> 5;
    const int t0 = qt * 64, tq = t0 + qh * 32 + r32, head = g * 4 + r;
    const size_t zrow = (size_t)(b * SEQ + tq) * ZP;
    LAS float* BIAS = (LAS float*)(lds + L_BIAS);
    LAS float* IMPV = (LAS float*)(lds + L_IMPV);
    LAS unsigned* SEL = (LAS unsigned*)(lds + L_SEL);
    LAS float* SSQ = (LAS float*)(lds + L_SSQ);
    bf16x8 qf[4];
#pragma unroll
    for (int d0 = 0; d0 < 4; ++d0) { const v4u w = *(const v4u*)(T.z + zrow + C_Q + head * 64 + d0 * 16 + hh * 8);
        v4u qs; qs.x = cvtpk(bflo(w.x) * C1, bfhi(w.x) * C1); qs.y = cvtpk(bflo(w.y) * C1, bfhi(w.y) * C1); qs.z = cvtpk(bflo(w.z) * C1, bfhi(w.z) * C1); qs.w = cvtpk(bflo(w.w) * C1, bfhi(w.w) * C1);
        qf[d0] = __builtin_bit_cast(bf16x8, qs); }
    const float g_c = sigmoidf_(bf2f(T.z[zrow + C_GT + head * 3 + 0])), g_s = sigmoidf_(bf2f(T.z[zrow + C_GT + head * 3 + 1])), g_w = sigmoidf_(bf2f(T.z[zrow + C_GT + head * 3 + 2]));
    f32x16 yacc[2];
#pragma unroll
    for (int i = 0; i < 16; ++i) { yacc[0][i] = 0.f; yacc[1][i] = 0.f; }
    const bool two = (qt >= 16);
    { const int skey = tid >> 3, sch = tid & 7;
      const bf16* kc = T.kcvc + (size_t)((b * 4 + g) * 128) * 64, *vc = kc + (size_t)64 * 128 * 64;
      const int nt = two ? 2 : 1;
      for (int tt = 0; tt < nt; ++tt) {
          *(LAS v4u*)(lds + L_K + tt * KBUF + skey * KPB + sch * 16) = *(const v4u*)(kc + (size_t)(tt * 64 + skey) * 64 + sch * 8);
          *(LAS v4u*)(lds + L_V + tt * VBUF + skey * VPB + sch * 16) = *(const v4u*)(vc + (size_t)(tt * 64 + skey) * 64 + sch * 8);
      } }
    LAS unsigned* PSUMU = (LAS unsigned*)(lds + L_PSUM);
    if (two) { for (int u = tid; u < 128 * 65; u += 512) PSUMU[u] = 0u; }
    __syncthreads();
    const LAS float* biasr = BIAS + r * 128; const float bfar = biasr[127];
    NSA_MARK(0);
    { const int nt = two ? 2 : 1;
      float negm = 0.f, lacc = 0.f; f32x16 o[2];
#pragma unroll
      for (int i = 0; i < 16; ++i) { o[0][i] = 0.f; o[1][i] = 0.f; }
#pragma unroll 1
      for (int tt = 0; tt < nt; ++tt)
          tile_step<16, true>(lds + L_K + tt * KBUF, lds + L_V + tt * VBUF, qf, negm, o, lacc, tt == 0, true, bfar, tq - 31 - tt * 1024, 0x7fffffff, biasr, lane);
      const float lsum = lacc + __shfl_xor(lacc, 32);
      const float sc = (tq >= 31) ? g_c * __builtin_amdgcn_rcpf(lsum) : 0.f;
#pragma unroll
      for (int i = 0; i < 16; ++i) { yacc[0][i] = sc * o[0][i]; yacc[1][i] = sc * o[1][i]; }
      if (two) {
          const int qc = qh * 32 + r32; const float fx = 268435456.0f / lsum;
#pragma unroll 1
          for (int tt = 0; tt < 2; ++tt) {
              f32x16 a0, a1;
              qk_tile(a0, a1, lds + L_K + tt * KBUF, qf, r32, hh);
              gen_fix<16>(a0, a1, tq - 31 - tt * 1024, 0x7fffffff, true, negm, biasr, hh);
              LAS unsigned* pb = PSUMU + (tt * 64 + 4 * hh) * 65 + qc;
#pragma unroll
              for (int i = 0; i < 16; ++i) { const int ci = (i & 3) + 8 * (i >> 2);
                  __hip_atomic_fetch_add(pb + ci * 65, (unsigned)(__builtin_amdgcn_exp2f(a0[i]) * fx + 0.5f), __ATOMIC_RELAXED, __HIP_MEMORY_SCOPE_WORKGROUP);
                  __hip_atomic_fetch_add(pb + (ci + 32) * 65, (unsigned)(__builtin_amdgcn_exp2f(a1[i]) * fx + 0.5f), __ATOMIC_RELAXED, __HIP_MEMORY_SCOPE_WORKGROUP); }
          }
      }
    }
    __syncthreads();
    NSA_MARK(1);
    if (two) {
#pragma unroll 1
        for (int ps = 0; ps < 4; ++ps) {
            const int q = ps * 16 + 2 * wid + hh, j = r32;
            const int dblk = qt - j;
            float v;
            if (j == 0 || (dblk >= 0 && dblk < 2)) v = 1.0e4f;
            else if (dblk < 0) v = -1.0e4f;
            else { const LAS unsigned* pc = PSUMU + (4 * j) * 65 + q; v = ((float)pc[-65] + 2.f * (float)pc[0] + 2.f * (float)pc[65] + 2.f * (float)pc[130] + (float)pc[195]) * (1.0f / 268435456.0f); }
            IMPV[q * 32 + j] = v;
        }
        __syncthreads();
#pragma unroll 1
        for (int ps = 0; ps < 4; ++ps) {
            const int q = ps * 16 + 2 * wid + hh, j = r32;
            const float v = IMPV[q * 32 + j]; int rank = 0;
#pragma unroll
            for (int jj = 0; jj < 32; ++jj) { const float o = IMPV[q * 32 + jj]; rank += (o > v || (o == v && jj < j)) ? 1 : 0; }
            const unsigned long long bal = __ballot(rank < 16);
            if (r32 == 0) SEL[q] = hh ? (unsigned)(bal >> 32) : (unsigned)bal;
        }
        __syncthreads();
    }
    const unsigned selmask = two ? SEL[qh * 32 + r32] : 0xffffffffu;
    __syncthreads();
    NSA_MARK(2);
    LAS char* stash = lds + L_STASH + wid * 8192 + lane * 16;
#pragma unroll
    for (int db = 0; db < 2; ++db)
#pragma unroll
        for (int i4 = 0; i4 < 4; ++i4) *(LAS f32x4*)(stash + (db * 4 + i4) * 1024) = (f32x4){yacc[db][4 * i4], yacc[db][4 * i4 + 1], yacc[db][4 * i4 + 2], yacc[db][4 * i4 + 3]};
    branches(lds, T, b, g, qt, tq, qf, biasr, bfar, selmask, g_s, g_w, stash, tid, lane);
    NSA_MARK(3);
#pragma unroll
    for (int db = 0; db < 2; ++db)
#pragma unroll
        for (int i4 = 0; i4 < 4; ++i4) { const f32x4 y = *(const LAS f32x4*)(stash + (db * 4 + i4) * 1024); yacc[db][4 * i4] = y.x; yacc[db][4 * i4 + 1] = y.y; yacc[db][4 * i4 + 2] = y.z; yacc[db][4 * i4 + 3] = y.w; }
    { int tid2 = threadIdx.x; asm volatile("" : "+v"(tid2));
      const int tq2 = t0 + ((tid2 >> 6) & 1) * 32 + (tid2 & 31);
      bf16* yp = T.y + (size_t)(b * SEQ + tq2) * DM + LRUW + (g * 4 + (tid2 >> 7)) * 64;
      float ss = 0.f;
#pragma unroll
      for (int db = 0; db < 2; ++db)
#pragma unroll
          for (int i4 = 0; i4 < 4; ++i4) {
              const float v0 = yacc[db][4 * i4], v1 = yacc[db][4 * i4 + 1], v2 = yacc[db][4 * i4 + 2], v3 = yacc[db][4 * i4 + 3];
              ss += (v0 * v0 + v1 * v1) + (v2 * v2 + v3 * v3);
              v2u w; w.x = cvtpk(v0, v1); w.y = cvtpk(v2, v3);
              *(v2u*)(yp + db * 32 + 8 * i4 + 4 * hh) = w;
          }
      ss += __shfl_xor(ss, 32);
      if (hh == 0) SSQ[r * 64 + qh * 32 + r32] = ss;
      __syncthreads();
      if (tid < 64) T.ssn[(size_t)(b * SEQ + t0 + tid) * 4 + g] = (SSQ[tid] + SSQ[64 + tid]) + (SSQ[128 + tid] + SSQ[192 + tid]);
      __syncthreads(); }
    NSA_MARK(4);
}
#undef NSA_MFMA
}
namespace lru {
constexpr int TC = 128;
constexpr int L_XF = 0, L_AF = 32768, L_XB = 65536, XBP = 144, L_SEG = L_XB + TC * XBP, L_CARRY = L_SEG + 4096, L_SQ = L_CARRY + 256, L_END = L_SQ + TC * 65 * 4;
static_assert(L_END <= RING_BYTES, "lru LDS");
typedef float f32x4_ __attribute__((ext_vector_type(4)));
struct Tens { const bf16* z; const float *conv_w, *conv_b, *wa, *ba, *wx, *bx, *lam; bf16* y; float* ssl; };

__device__ __forceinline__ void unit(LAS char* lds, const Tens& T, int b, int n) {
    const int tid = threadIdx.x, lane = tid & 63, w = __builtin_amdgcn_readfirstlane(tid >> 6);
    const int c = lane, ch = n * 64 + c;
    LAS float* XF = (LAS float*)(lds + L_XF); LAS float* AF = (LAS float*)(lds + L_AF);
    LAS float* SEGA = (LAS float*)(lds + L_SEG); LAS float* SEGH = SEGA + 512;
    LAS float* CARRY = (LAS float*)(lds + L_CARRY); LAS float* YSQ = (LAS float*)(lds + L_SQ);
    const float cw0 = T.conv_w[ch], cw1 = T.conv_w[1024 + ch], cw2 = T.conv_w[2048 + ch], cw3 = T.conv_w[3072 + ch], cb = T.conv_b[ch];
    bf16x8 fwa[4][2], fwx[4][2]; float bar[4], bxr[4], clc[4];
    { const int kq = lane >> 4, jc = lane & 15;
#pragma unroll
      for (int cb4 = 0; cb4 < 4; ++cb4) {
          const int col = 16 * cb4 + jc;
#pragma unroll
          for (int ks = 0; ks < 2; ++ks) {
              unsigned short ea[8], ex[8];
#pragma unroll
              for (int e = 0; e < 8; ++e) { const size_t o = (size_t)n * 4096 + (size_t)(8 * kq + e + 32 * ks) * 64 + col; ea[e] = (unsigned short)f2bf(T.wa[o]); ex[e] = (unsigned short)f2bf(T.wx[o]); }
              fwa[cb4][ks] = (bf16x8){(short)ea[0], (short)ea[1], (short)ea[2], (short)ea[3], (short)ea[4], (short)ea[5], (short)ea[6], (short)ea[7]};
              fwx[cb4][ks] = (bf16x8){(short)ex[0], (short)ex[1], (short)ex[2], (short)ex[3], (short)ex[4], (short)ex[5], (short)ex[6], (short)ex[7]};
          }
          bar[cb4] = T.ba[n * 64 + col]; bxr[cb4] = T.bx[n * 64 + col];
          const float lm = T.lam[n * 64 + col];
          clc[cb4] = -8.0f * log1pf(expf(-lm)) * LOG2E;
      } }
    if (tid < 64) CARRY[tid] = 0.f;
    const bf16* zu = T.z + (size_t)b * SEQ * ZP + C_U + ch;
    const bf16* zg = T.z + (size_t)b * SEQ * ZP + C_GL + ch;
#pragma unroll 1
    for (int chunk = 0; chunk < SEQ / TC; ++chunk) {
        const int tb = chunk * TC + 16 * w;
        unsigned short gl[16];
#pragma unroll
        for (int i = 0; i < 16; ++i) gl[i] = zg[(size_t)(tb + i) * ZP];
        float uu[19];
#pragma unroll
        for (int k = 0; k < 19; ++k) { const int t = tb - 3 + k; uu[k] = (t >= 0) ? bf2f(zu[(size_t)t * ZP]) : 0.f; }
#pragma unroll
        for (int i = 0; i < 16; ++i) {
            const float xc = cb + cw0 * uu[i] + cw1 * uu[i + 1] + cw2 * uu[i + 2] + cw3 * uu[i + 3];
            XF[(16 * w + i) * 64 + c] = xc;
            *(LAS unsigned short*)(lds + L_XB + (16 * w + i) * XBP + c * 2) = (unsigned short)f2bf(xc);
        }
        __syncthreads();
        { const int kq = lane >> 4, jc = lane & 15;
          const bf16x8 fa0 = *(const LAS bf16x8*)(lds + L_XB + (16 * w + jc) * XBP + (8 * kq) * 2), fa1 = *(const LAS bf16x8*)(lds + L_XB + (16 * w + jc) * XBP + (8 * kq + 32) * 2);
#pragma unroll
          for (int cb4 = 0; cb4 < 4; ++cb4) {
              f32x4_ ar = {0.f, 0.f, 0.f, 0.f}, ax = {0.f, 0.f, 0.f, 0.f};
              ar = __builtin_amdgcn_mfma_f32_16x16x32_bf16(fa0, fwa[cb4][0], ar, 0, 0, 0); ar = __builtin_amdgcn_mfma_f32_16x16x32_bf16(fa1, fwa[cb4][1], ar, 0, 0, 0);
              ax = __builtin_amdgcn_mfma_f32_16x16x32_bf16(fa0, fwx[cb4][0], ax, 0, 0, 0); ax = __builtin_amdgcn_mfma_f32_16x16x32_bf16(fa1, fwx[cb4][1], ax, 0, 0, 0);
              const int col = 16 * cb4 + jc;
#pragma unroll
              for (int e = 0; e < 4; ++e) {
                  const int tt = 16 * w + 4 * kq + e;
                  const float rg = sigmoidf_(ar[e] + bar[cb4]), ig = sigmoidf_(ax[e] + bxr[cb4]);
                  const float a = __builtin_amdgcn_exp2f(clc[cb4] * rg);
                  const float xcv = XF[tt * 64 + col];
                  AF[tt * 64 + col] = a;
                  XF[tt * 64 + col] = __builtin_amdgcn_sqrtf(fmaxf(1.0f - a * a, 0.f)) * (ig * xcv);
              }
          } }
        __syncthreads();
        float av[16], bv[16];
#pragma unroll
        for (int i = 0; i < 16; ++i) { av[i] = AF[(16 * w + i) * 64 + c]; bv[i] = XF[(16 * w + i) * 64 + c]; }
        { float A = 1.f, H = 0.f;
#pragma unroll
          for (int i = 0; i < 16; ++i) { H = av[i] * H + bv[i]; A *= av[i]; }
          SEGA[w * 64 + c] = A; SEGH[w * 64 + c] = H; }
        __syncthreads();
        float h = CARRY[c];
        for (int s = 0; s < w; ++s) h = SEGA[s * 64 + c] * h + SEGH[s * 64 + c];
        bf16* yp = T.y + (size_t)(b * SEQ + tb) * DM + ch;
#pragma unroll
        for (int i = 0; i < 16; ++i) {
            h = av[i] * h + bv[i];
            const float yv = h * pg8::gelu_tanh(bf2f(gl[i]));
            yp[(size_t)i * DM] = (bf16)f2bf(yv);
            YSQ[(16 * w + i) * 65 + c] = yv * yv;
        }
        __syncthreads();
        if (w == 7) CARRY[c] = h;
        if (tid < TC) { float s = 0.f;
#pragma unroll 8
            for (int k = 0; k < 64; ++k) s += YSQ[tid * 65 + k];
            T.ssl[(size_t)(b * SEQ + chunk * TC + tid) * 16 + n] = s; }
    }
    __syncthreads();
}
}
struct Frame {
    LAS unsigned char* lds; volatile LAS unsigned* MISC; gu32* ctl;
    int tid, lane, wave, vcu, G;
};
struct Args { const float* in[28]; float* out; unsigned char* ws; int ph_lo, ph_hi; };

__device__ __forceinline__ void p0_transpose_item(const float* W, int K, int N, int NP, bf16* WT, LAS float* scr, int item, int lane, const float* kscale = nullptr) {
    const int nblk = NP / 32, kb = item / nblk, nb = item % nblk, k0 = 64 * kb, n0 = 32 * nb;
    const int nn = n0 + (lane & 31);
    float wv[32];
#pragma unroll
    for (int i = 0; i < 32; ++i) { const int kk = 2 * i + (lane >> 5); wv[i] = (nn < N) ? W[(size_t)(k0 + kk) * N + nn] : 0.f; }
    if (kscale) {
#pragma unroll
        for (int i = 0; i < 32; ++i) wv[i] *= kscale[k0 + 2 * i + (lane >> 5)]; }
#pragma unroll
    for (int i = 0; i < 32; ++i) scr[(2 * i + (lane >> 5)) * 33 + (lane & 31)] = wv[i];
    LDS_WAIT(); asm volatile("" ::: "memory");
    const int c = lane & 7;
#pragma unroll
    for (int j = 0; j < 4; ++j) { const int n = (lane >> 3) + 8 * j; const LAS float* s = scr + (8 * c) * 33 + n;
        v4u o; o.x = pk2(s[0 * 33], s[1 * 33]); o.y = pk2(s[2 * 33], s[3 * 33]); o.z = pk2(s[4 * 33], s[5 * 33]); o.w = pk2(s[6 * 33], s[7 * 33]);
        *(GAS v4u*)(WT + (size_t)(n0 + n) * K + k0 + 8 * c) = o; }
    LDS_WAIT(); asm volatile("" ::: "memory");
}
__device__ __forceinline__ void rms_row_to_bf16(const float* xrow, const float* g, bf16* orow, int lane) {
    f32x4 v[8]; float s = 0.f;
#pragma unroll
    for (int j = 0; j < 8; ++j) { v[j] = *(const f32x4*)(xrow + 4 * (lane + 64 * j)); s += (v[j].x * v[j].x + v[j].y * v[j].y) + (v[j].z * v[j].z + v[j].w * v[j].w); }
    const float rs = 1.0f / sqrtf(wave_sum(s) * (1.0f / DM) + NORM_EPS);
#pragma unroll
    for (int j = 0; j < 8; ++j) { const f32x4 gg = *(const f32x4*)(g + 4 * (lane + 64 * j)); v2u o; o.x = pk2(v[j].x * rs * gg.x, v[j].y * rs * gg.y); o.y = pk2(v[j].z * rs * gg.z, v[j].w * rs * gg.w);
        *(v2u*)(orow + 4 * (lane + 64 * j)) = o; }
}

__global__ void __launch_bounds__(NWAVES * 64, 2) hymba_fwd(Args args) {
    extern __shared__ __attribute__((aligned(16))) unsigned char lds[];
    Frame F;
    F.lds = (LAS unsigned char*)lds; F.MISC = (volatile LAS unsigned*)(F.lds + MISC_OFF);
    F.tid = threadIdx.x; F.lane = F.tid & 63; F.wave = __builtin_amdgcn_readfirstlane(F.tid >> 6);
    F.G = gridDim.x; { const int bx = blockIdx.x; F.vcu = (F.G % 8 == 0) ? (bx % 8) * (F.G / 8) + bx / 8 : bx; }
    unsigned char* ws = args.ws;
    F.ctl = (gu32*)(ws + WS_CTL);
    for (int u = F.tid; u < (LDS_BYTES - LDSCTL_OFF) / 4; u += NWAVES * 64) ((LAS unsigned*)(F.lds + LDSCTL_OFF))[u] = 0u;
    __syncthreads();
    XcdBarrier bar = xcd_barrier_post((unsigned*)(F.ctl + CW_BAR), F.MISC + 8);
    const int lo = args.ph_lo, hi = args.ph_hi;
#ifndef PHMASK
#define PHMASK 0xfff
#endif
#define IN(k) (((PHMASK >> (k)) & 1) && lo <= (k) && (k) < hi)
#ifndef REP_MASK
#define REP_MASK 0
#endif
#ifndef PROBE_MODE
#define PROBE_MODE 0
#endif
#ifndef PROBE_PH
#define PROBE_PH 8
#endif
#define TS ((volatile LAS unsigned long long*)(LDSCTL_OFF + 1024))
#define STAMP(k) do { if (PROBE_MODE && blockIdx.x == 0 && F.tid == 0) { TS[2 * (k)] = __builtin_amdgcn_s_memrealtime(); TS[2 * (k) + 1] = (unsigned long long)clock64(); } } while (0)
#define PH_BEGIN(k) if (IN(k)) { STAMP(k); for (int rep_ = 0; rep_ < ((REP_MASK >> (k)) & 1) + 1; ++rep_) { if (rep_) xcd_barrier(bar);
#define PH_END() } }
#define SEAM(k) do { if (IN(k) && IN((k) + 1)) xcd_barrier(bar); } while (0)
#define x_in (args.in[0])
#define p_in (args.in[1])
#define g_mix_pre (args.in[2])
#define g_mix_post (args.in[3])
#define g_mlp_pre (args.in[4])
#define g_mlp_post (args.in[5])
#define w_in (args.in[6])
#define conv_w (args.in[7])
#define conv_b (args.in[8])
#define lru_wa (args.in[9])
#define lru_ba (args.in[10])
#define lru_wx (args.in[11])
#define lru_bx (args.in[12])
#define lru_lam (args.in[13])
#define pe_k (args.in[14])
#define cw1_k (args.in[15])
#define cw2_k (args.in[16])
#define pe_v (args.in[17])
#define cw1_v (args.in[18])
#define cw2_v (args.in[19])
#define rel_bias (args.in[20])
#define gn_lru (args.in[21])
#define gn_nsa (args.in[22])
#define w_out (args.in[23])
#define mlp_w1 (args.in[24])
#define mlp_w2 (args.in[25])
#define ple_gate (args.in[26])
#define ple_proj (args.in[27])
    float* out = args.out;
    bf16 *Win_t = (bf16*)(ws + WS_WIN), *Wout_t = (bf16*)(ws + WS_WOUT), *W1_t = (bf16*)(ws + WS_W1), *W2_t = (bf16*)(ws + WS_W2), *Wg_t = (bf16*)(ws + WS_WG), *Wp_t = (bf16*)(ws + WS_WP);
    bf16 *Cw1k_t = (bf16*)(ws + WS_CW1K), *Cw1v_t = (bf16*)(ws + WS_CW1V);
    float* b1part = (float*)(ws + WS_MISC); float* bias1 = (float*)(ws + WS_MISC + 65536); float* RS = (float*)(ws + WS_MISC + 131072);
    bf16* PB = (bf16*)(ws + WS_PB); bf16* HIDP = (bf16*)(ws + WS_HIDP); bf16* KCVC = (bf16*)(ws + WS_KCVC);
    float *SSL = (float*)(ws + WS_SSL), *SSN = (float*)(ws + WS_SSN), *SSQ = (float*)(ws + WS_SSQ);
    bf16* XB = (bf16*)(ws + WS_A);
    float* RSX = (float*)(ws + WS_MISC + 262144);
    bf16 *A = (bf16*)(ws + WS_A), *Z = (bf16*)(ws + WS_Z), *Y = (bf16*)(ws + WS_Y), *TT = (bf16*)(ws + WS_T), *HID2 = (bf16*)(ws + WS_HID2), *FF = (bf16*)(ws + WS_F), *PP = (bf16*)(ws + WS_PP);
    const int gw = F.vcu * NWAVES + F.wave, NGW = F.G * NWAVES;

    PH_BEGIN(0)
        LAS float* scr = (LAS float*)(F.lds + RING_OFF + F.wave * 16384);
        constexpr int I_IN = (DM / 64) * (ZP / 32), I_OUT = (DM / 64) * (DM / 32), I_1 = (DM / 64) * (DFF / 32), I_2 = (DFF / 64) * (DM / 32), I_G = I_OUT, I_P = (PLE / 64) * (DM / 32), I_C = (CMP_K / 64) * (CMP_H / 32);
        constexpr int NITEMS = I_IN + I_OUT + I_1 + I_2 + I_G + I_P + 2 * I_C;
        for (int it = gw; it < NITEMS; it += NGW) {
            int r = it;
            if (r < I_IN) { p0_transpose_item(w_in, DM, IN_DIM, ZP, Win_t, scr, r, F.lane, g_mix_pre); continue; } r -= I_IN;
            if (r < I_OUT) { p0_transpose_item(w_out, DM, DM, DM, Wout_t, scr, r, F.lane, (r / (DM / 32)) < 16 ? gn_lru : gn_nsa - LRUW); continue; } r -= I_OUT;
            if (r < I_1) { p0_transpose_item(mlp_w1, DM, DFF, DFF, W1_t, scr, r, F.lane, g_mlp_pre); continue; } r -= I_1;
            if (r < I_2) { p0_transpose_item(mlp_w2, DFF, DM, DM, W2_t, scr, r, F.lane); continue; } r -= I_2;
            if (r < I_G) { p0_transpose_item(ple_gate, DM, DM, DM, Wg_t, scr, r, F.lane); continue; } r -= I_G;
            if (r < I_P) { p0_transpose_item(ple_proj, PLE, DM, DM, Wp_t, scr, r, F.lane); continue; } r -= I_P;
            if (r < I_C) { p0_transpose_item(cw1_k, CMP_K, CMP_H, CMP_H, Cw1k_t, scr, r, F.lane); continue; } r -= I_C;
            p0_transpose_item(cw1_v, CMP_K, CMP_H, CMP_H, Cw1v_t, scr, r, F.lane);
        }
        for (int m = gw; m < MTOK; m += 2 * NGW) {
            const int m2 = m + NGW; const bool h2 = m2 < MTOK; const float* x0 = x_in + (size_t)m * DM; const float* x1 = x_in + (size_t)(h2 ? m2 : m) * DM;
            f32x4 v0[8], v1[8]; float s0 = 0.f, s1 = 0.f;
#pragma unroll
            for (int j = 0; j < 8; ++j) { v0[j] = *(const f32x4*)(x0 + 4 * (F.lane + 64 * j)); v1[j] = *(const f32x4*)(x1 + 4 * (F.lane + 64 * j)); }
#pragma unroll
            for (int j = 0; j < 8; ++j) { s0 += (v0[j].x * v0[j].x + v0[j].y * v0[j].y) + (v0[j].z * v0[j].z + v0[j].w * v0[j].w); s1 += (v1[j].x * v1[j].x + v1[j].y * v1[j].y) + (v1[j].z * v1[j].z + v1[j].w * v1[j].w);
                v2u o; o.x = pk2(v0[j].x, v0[j].y); o.y = pk2(v0[j].z, v0[j].w); *(v2u*)(XB + (size_t)m * DM + 4 * (F.lane + 64 * j)) = o;
                if (h2) { v2u q; q.x = pk2(v1[j].x, v1[j].y); q.y = pk2(v1[j].z, v1[j].w); *(v2u*)(XB + (size_t)m2 * DM + 4 * (F.lane + 64 * j)) = q; } }
            s0 = wave_sum(s0); s1 = wave_sum(s1);
            if (F.lane == 0) { RSX[m] = 1.0f / sqrtf(s0 * (1.0f / DM) + NORM_EPS); if (h2) RSX[m2] = 1.0f / sqrtf(s1 * (1.0f / DM) + NORM_EPS); }
        }
        for (int m = gw; m < MTOK; m += 4 * NGW) { f32x4 v[4];
#pragma unroll
            for (int u = 0; u < 4; ++u) { const int mm = m + u * NGW; v[u] = *(const f32x4*)(p_in + (size_t)(mm < MTOK ? mm : m) * PLE + 4 * F.lane); }
#pragma unroll
            for (int u = 0; u < 4; ++u) { const int mm = m + u * NGW; if (mm < MTOK) { v2u o; o.x = pk2(v[u].x, v[u].y); o.y = pk2(v[u].z, v[u].w); *(v2u*)(PB + (size_t)mm * PLE + 4 * F.lane) = o; } } }
        for (int it = gw; it < 256; it += NGW) {
            const int ten = it >> 7, ks = (it >> 3) & 15, cg = it & 7, col = cg * 32 + (F.lane & 31), kh = F.lane >> 5;
            const float* pe = ten ? pe_v : pe_k; const float* w1 = ten ? cw1_v : cw1_k; float s = 0.f;
            for (int k = 0; k < 64; ++k) { const int kk = ks * 128 + kh * 64 + k; s += pe[kk] * w1[(size_t)kk * CMP_H + col]; }
            s += __shfl_xor(s, 32);
            if (kh == 0) b1part[(ten * 16 + ks) * 256 + col] = s;
        }
    PH_END()
    SEAM(0);
    PH_BEGIN(1)
        if (blockIdx.x == 0) { const int ten = F.tid >> 8, col = F.tid & 255; float s = 0.f;
            for (int ks = 0; ks < 16; ++ks) s += b1part[(ten * 16 + ks) * 256 + col];
            bias1[ten * 256 + col] = s; }
        pg8::Gemm g{XB, Win_t, MTOK, ZP, DM}; pg8::StaticOrder S; S.init(MTOK, ZP, F.G, (int)blockIdx.x);
        pg8::EpiAct<0> E{Z, ZP, nullptr, RSX};
        pg8::gemm_phase<pg8::EpiAct<0>, pg8::StaticOrder, pg8::AMapPlain, true, true>(F.lds + RING_OFF, g, S, E);
    PH_END()
    SEAM(1);
    PH_BEGIN(2)
        { lru::Tens T{Z, conv_w, conv_b, lru_wa, lru_ba, lru_wx, lru_bx, lru_lam, Y, SSL};
          for (int u = F.vcu; u < BATCH * 16; u += F.G) lru::unit((LAS char*)F.lds, T, u >> 4, u & 15); }
        { static_assert(WS_CW1V - WS_CW1K == (1u << 20), "AMapCmp4 finds the V branch's w1^T 1 MiB behind the K branch's");
          pg8::Gemm g{Z, Cw1k_t, 65536, CMP_H, 512}; pg8::StaticOrder S; S.init(65536, CMP_H, F.G, (int)blockIdx.x);
          pg8::EpiAct<0> E{HIDP, CMP_H, nullptr, nullptr};
          pg8::gemm_phase<pg8::EpiAct<0>, pg8::StaticOrder, pg8::AMapCmp4, false, true>(F.lds + RING_OFF, g, S, E); }
    PH_END()
    SEAM(2);
    PH_BEGIN(3)
        for (int it = F.vcu * 512 + F.tid; it < 2 * 8192 * 8; it += F.G * 512) {
            const int row = it >> 3, c8 = it & 7, ten = row >> 13, r13 = row & 8191;
            const float* w2 = (ten ? cw2_v : cw2_k) + c8 * 8; const float* b1 = bias1 + ten * 256;
            float acc[8] = {0.f, 0.f, 0.f, 0.f, 0.f, 0.f, 0.f, 0.f};
            if ((row & 127) != 127) {
                const bf16* hp = HIDP + ((size_t)(ten * 4) * 8192 + r13) * CMP_H;
                for (int k8 = 0; k8 < 32; ++k8) {
                    const v4u h0 = *(const v4u*)(hp + k8 * 8), h1 = *(const v4u*)(hp + (size_t)8192 * CMP_H + k8 * 8), h2 = *(const v4u*)(hp + (size_t)2 * 8192 * CMP_H + k8 * 8), h3 = *(const v4u*)(hp + (size_t)3 * 8192 * CMP_H + k8 * 8);
                    const f32x4 ba = *(const f32x4*)(b1 + k8 * 8), bb = *(const f32x4*)(b1 + k8 * 8 + 4);
                    const unsigned u0[4] = {h0.x, h0.y, h0.z, h0.w}, u1[4] = {h1.x, h1.y, h1.z, h1.w}, u2[4] = {h2.x, h2.y, h2.z, h2.w}, u3[4] = {h3.x, h3.y, h3.z, h3.w};
                    const float bs[8] = {ba.x, ba.y, ba.z, ba.w, bb.x, bb.y, bb.z, bb.w};
#pragma unroll
                    for (int e = 0; e < 8; ++e) {
                        const float pre = (e & 1) ? ((bfhi(u0[e >> 1]) + bfhi(u1[e >> 1])) + (bfhi(u2[e >> 1]) + bfhi(u3[e >> 1])) + bs[e]) : ((bflo(u0[e >> 1]) + bflo(u1[e >> 1])) + (bflo(u2[e >> 1]) + bflo(u3[e >> 1])) + bs[e]);
                        const float hv = pg8::gelu_tanh(pre);
                        const f32x4 wa = *(const f32x4*)(w2 + (size_t)(k8 * 8 + e) * 64), wb = *(const f32x4*)(w2 + (size_t)(k8 * 8 + e) * 64 + 4);
                        acc[0] += hv * wa.x; acc[1] += hv * wa.y; acc[2] += hv * wa.z; acc[3] += hv * wa.w; acc[4] += hv * wb.x; acc[5] += hv * wb.y; acc[6] += hv * wb.z; acc[7] += hv * wb.w; }
                }
            }
            v4u o; o.x = pk2(acc[0], acc[1]); o.y = pk2(acc[2], acc[3]); o.z = pk2(acc[4], acc[5]); o.w = pk2(acc[6], acc[7]);
            *(v4u*)(KCVC + (size_t)row * 64 + c8 * 8) = o;
        }
    PH_END()
    SEAM(3);
    PH_BEGIN(4)
        nsa::Tens T{Z, KCVC, rel_bias, Y, SSN};
        for (int v = F.vcu; v < 256; v += F.G) {
            const int bg = v >> 2, k = v & 3;
            __syncthreads(); nsa::fill_bias((LAS char*)F.lds, rel_bias, bg & 3);
#pragma unroll 1
            for (int i = 7; i >= 0; --i) { const int qt = 8 * (i >> 1) + ((i & 1) ? 7 - k : k); nsa::unit((LAS char*)F.lds, T, bg >> 2, bg & 3, qt); }
        }
    PH_END()
    SEAM(4);
    PH_BEGIN(6)
        pg8::Gemm g{Y, Wout_t, MTOK, DM, DM}; pg8::StaticOrder S; S.init(MTOK, DM, F.G, (int)blockIdx.x);
        LAS float* tab = (LAS float*)(F.lds + LDSCTL_OFF + 4096);
        for (int i = F.wave >> 2; i < 4; i += 2) { pg8::Unit u;
            if (S.next(i, u)) { const int r = F.tid & 255; const size_t row = (size_t)u.pm * 256 + r;
                const f32x4 a0 = *(const f32x4*)(SSL + row * 16), a1 = *(const f32x4*)(SSL + row * 16 + 4), a2 = *(const f32x4*)(SSL + row * 16 + 8), a3 = *(const f32x4*)(SSL + row * 16 + 12), n0 = *(const f32x4*)(SSN + row * 4);
                const float sl = ((a0.x + a0.y) + (a0.z + a0.w)) + ((a1.x + a1.y) + (a1.z + a1.w)) + ((a2.x + a2.y) + (a2.z + a2.w)) + ((a3.x + a3.y) + (a3.z + a3.w)), sn = (n0.x + n0.y) + (n0.z + n0.w);
                const float rl = 1.0f / sqrtf(sl * (1.0f / 1024.f) + NORM_EPS), rn = 1.0f / sqrtf(sn * (1.0f / 1024.f) + NORM_EPS);
                tab[(i * 256 + r) * 2] = rl / rn; tab[(i * 256 + r) * 2 + 1] = rn; } }
        __syncthreads();
        pg8::EpiSsqY E{TT, DM, SSQ, tab};
        pg8::gemm_phase<pg8::EpiSsqY, pg8::StaticOrder, pg8::AMapPlain, true, true>(F.lds + RING_OFF, g, S, E);
    PH_END()
    SEAM(6);
    PH_BEGIN(7)
        for (int m = gw; m < MTOK; m += NGW) {
            float sq = (F.lane < 32) ? SSQ[(size_t)m * 32 + F.lane] : 0.f; sq = wave_sum(sq);
            const float rt = 1.0f / sqrtf(sq * (1.0f / DM) + NORM_EPS);
            const bf16* tr = TT + (size_t)m * DM; const bf16* xr = XB + (size_t)m * DM; bf16* ar = A + (size_t)m * DM;
            float s2 = 0.f;
#pragma unroll
            for (int j = 0; j < 4; ++j) { const int c0 = 8 * (F.lane + 64 * j);
                const v4u w = *(const v4u*)(tr + c0), xw = *(const v4u*)(xr + c0); const f32x4 g0 = *(const f32x4*)(g_mix_post + c0), g1 = *(const f32x4*)(g_mix_post + c0 + 4);
                const f32x4 x0 = {bflo(xw.x), bfhi(xw.x), bflo(xw.y), bfhi(xw.y)}, x1 = {bflo(xw.z), bfhi(xw.z), bflo(xw.w), bfhi(xw.w)};
                f32x4 h0, h1;
                h0.x = x0.x + bflo(w.x) * rt * g0.x; h0.y = x0.y + bfhi(w.x) * rt * g0.y; h0.z = x0.z + bflo(w.y) * rt * g0.z; h0.w = x0.w + bfhi(w.y) * rt * g0.w;
                h1.x = x1.x + bflo(w.z) * rt * g1.x; h1.y = x1.y + bfhi(w.z) * rt * g1.y; h1.z = x1.z + bflo(w.w) * rt * g1.z; h1.w = x1.w + bfhi(w.w) * rt * g1.w;
                s2 += (h0.x * h0.x + h0.y * h0.y) + (h0.z * h0.z + h0.w * h0.w); s2 += (h1.x * h1.x + h1.y * h1.y) + (h1.z * h1.z + h1.w * h1.w);
                v4u o; o.x = pk2(h0.x, h0.y); o.y = pk2(h0.z, h0.w); o.z = pk2(h1.x, h1.y); o.w = pk2(h1.z, h1.w);
                *(v4u*)(ar + c0) = o; }
            s2 = wave_sum(s2);
            if (F.lane == 0) RS[m] = 1.0f / sqrtf(s2 * (1.0f / DM) + NORM_EPS);
        }
    PH_END()
    SEAM(7);
    PH_BEGIN(8)
        pg8::Gemm g{A, W1_t, MTOK, DFF, DM}; pg8::StaticOrder S; S.init(MTOK, DFF, F.G, (int)blockIdx.x);
        pg8::EpiAct<3> E{HID2, DFF, nullptr, RS};
        pg8::gemm_phase<pg8::EpiAct<3>, pg8::StaticOrder, pg8::AMapPlain, true, true>(F.lds + RING_OFF, g, S, E);
    PH_END()
    SEAM(8);
    PH_BEGIN(9)
        pg8::Gemm g{HID2, W2_t, MTOK, DM, DFF}; pg8::StaticOrder S; S.init(MTOK, DM, F.G, (int)blockIdx.x);
        pg8::EpiSsq E{FF, DM, SSQ};
        pg8::gemm_phase<pg8::EpiSsq, pg8::StaticOrder, pg8::AMapPlain, true, true>(F.lds + RING_OFF, g, S, E);
    PH_END()
    SEAM(9);
    PH_BEGIN(10)
        for (int m = gw; m < MTOK; m += NGW) {
            float sq = (F.lane < 32) ? SSQ[(size_t)m * 32 + F.lane] : 0.f; sq = wave_sum(sq);
            const float rf = 1.0f / sqrtf(sq * (1.0f / DM) + NORM_EPS);
            const bf16* fr_ = FF + (size_t)m * DM; bf16* ar = A + (size_t)m * DM;
#pragma unroll
            for (int j = 0; j < 4; ++j) { const int c0 = 8 * (F.lane + 64 * j);
                const v4u w = *(const v4u*)(fr_ + c0), hw = *(const v4u*)(ar + c0); const f32x4 g0 = *(const f32x4*)(g_mlp_post + c0), g1 = *(const f32x4*)(g_mlp_post + c0 + 4);
                v4u o; o.x = pk2(bflo(hw.x) + bflo(w.x) * rf * g0.x, bfhi(hw.x) + bfhi(w.x) * rf * g0.y); o.y = pk2(bflo(hw.y) + bflo(w.y) * rf * g0.z, bfhi(hw.y) + bfhi(w.y) * rf * g0.w);
                o.z = pk2(bflo(hw.z) + bflo(w.z) * rf * g1.x, bfhi(hw.z) + bfhi(w.z) * rf * g1.y); o.w = pk2(bflo(hw.w) + bflo(w.w) * rf * g1.z, bfhi(hw.w) + bfhi(w.w) * rf * g1.w);
                *(v4u*)(ar + c0) = o; }
        }
        VM_WAIT(); __syncthreads();
        int kple = PLE; asm volatile("" : "+s"(kple));
        pg8::Gemm g{PB, Wp_t, MTOK, DM, kple}; pg8::StaticOrder S; S.init(MTOK, DM, F.G, (int)blockIdx.x);
        pg8::EpiAct<0> E{PP, DM, nullptr, nullptr};
        pg8::gemm_phase<pg8::EpiAct<0>, pg8::StaticOrder, pg8::AMapPlain, true, true>(F.lds + RING_OFF, g, S, E);
    PH_END()
    SEAM(10);
    PH_BEGIN(11)
        pg8::Gemm g{A, Wg_t, MTOK, DM, DM}; pg8::StaticOrder S; S.init(MTOK, DM, F.G, (int)blockIdx.x);
        pg8::EpiGate E{out, A, PP, DM};
        pg8::gemm_phase<pg8::EpiGate, pg8::StaticOrder, pg8::AMapPlain, true, true>(F.lds + RING_OFF, g, S, E);
    PH_END()
#if PROBE_MODE
    STAMP(12);
    if (blockIdx.x == 0 && F.tid == 0) {
        const unsigned long long r0 = TS[2 * PROBE_PH], r1 = TS[2 * PROBE_PH + 2], c0 = TS[2 * PROBE_PH + 1], c1 = TS[2 * PROBE_PH + 3];
        unsigned long long ticks;
        if (PROBE_MODE >= 10) ticks = ((volatile LAS unsigned long long*)(LDSCTL_OFF + 1024 + 256))[PROBE_MODE - 10];
        else if (PROBE_MODE == 1) ticks = (c1 - c0) * 100ull / (r1 - r0) * 100ull;
        else ticks = (r1 - r0) * (unsigned long long)(PROBE_MODE - 1);
        const unsigned long long t0 = __builtin_amdgcn_s_memrealtime();
        while (__builtin_amdgcn_s_memrealtime() - t0 < ticks) __builtin_amdgcn_s_sleep(8);
    }
#endif
#undef IN
#undef SEAM
#undef x_in
#undef p_in
}

#ifndef MK_SPLIT
#define MK_SPLIT 0
#endif
extern "C" void kernel_launch(void* const* d_in, const int* in_sizes, int n_in, void* d_out, int out_size, void* d_ws, size_t ws_size, hipStream_t stream) {
    static int grid = 0;
    if (grid == 0) {
        if (n_in != 28 || out_size != MTOK * DM || ws_size < WS_END) { fprintf(stderr, "kernel_launch: unexpected shapes (n_in %d, out %d, ws %zu)\n", n_in, out_size, ws_size); grid = -1; return; }
        int dev = 0, cus = 0, per_cu = 0;
        if (hipGetDevice(&dev) != hipSuccess || hipDeviceGetAttribute(&cus, hipDeviceAttributeMultiprocessorCount, dev) != hipSuccess) { grid = -1; return; }
        if (hipFuncSetAttribute((const void*)hymba_fwd, hipFuncAttributeMaxDynamicSharedMemorySize, LDS_BYTES) != hipSuccess) { fprintf(stderr, "kernel_launch: hipFuncSetAttribute failed\n"); grid = -1; return; }
        if (hipOccupancyMaxActiveBlocksPerMultiprocessor(&per_cu, (const void*)hymba_fwd, NWAVES * 64, LDS_BYTES) != hipSuccess || per_cu < 1) { fprintf(stderr, "kernel_launch: occupancy query says %d\n", per_cu); (void)hipGetLastError(); }
        grid = cus;
    }
    if (grid < 0) return;
    (void)hipMemsetAsync((char*)d_ws + WS_CTL, 0, CTL_ZERO_BYTES, stream);
    Args a{};
    for (int i = 0; i < 28; ++i) a.in[i] = (const float*)d_in[i];
    a.out = (float*)d_out; a.ws = (unsigned char*)d_ws;
#if MK_SPLIT
    for (int ph = 0; ph < 12; ++ph) { a.ph_lo = ph; a.ph_hi = ph + 1; hipLaunchKernelGGL(hymba_fwd, dim3(grid), dim3(NWAVES * 64), LDS_BYTES, stream, a); }
#else
    a.ph_lo = 0; a.ph_hi = 12;
    hipLaunchKernelGGL(hymba_fwd, dim3(grid), dim3(NWAVES * 64), LDS_BYTES, stream, a);
#endif
}
```
